# Optimizing an MI355X kernel written in HIP

```python
import math
import jax
import jax.numpy as jnp
from jax import lax
import numpy as np

D_MODEL = 1024
BATCH = 1
SEQ = 16384
DEPTH = 4

MEM_LEN = 256
N_EVEN = (DEPTH + 1) // 2
N_ODD = DEPTH // 2
EPS = 1e-6
NEG_INF = -1e30

A_GROUPS = 4
A_CH = 128
A_WIDTH = A_GROUPS * A_CH
A_CHUNK = 128
B_HEADS = 8
B_KV_HEADS = 2
B_Q_PER_KV = B_HEADS // B_KV_HEADS
B_HEAD_DIM = 64
B_WIDTH = B_HEADS * B_HEAD_DIM
B_KV_WIDTH = B_KV_HEADS * B_HEAD_DIM
B_HALF_WINDOW = 128
B_BLOCK = 128
EVEN_IN = 2 * A_WIDTH + B_WIDTH + 2 * B_KV_WIDTH
EVEN_OUT = A_WIDTH + B_WIDTH
C_PAIRS = ((128, 1), (512, 4), (2048, 16))
C_GROUPS = len(C_PAIRS)
C_HEADS = 8
C_HEAD_DIM = 128
C_WIDTH = C_HEADS * C_HEAD_DIM
C_BLOCK = 64
ODD_IN = C_GROUPS * 3 * C_WIDTH
REL_BUCKETS = 32
REL_MAX_DIST = 1024
REL_HEADS = 8
X_HEADS = 4
X_HEAD_DIM = 128
X_WIDTH = X_HEADS * X_HEAD_DIM
MOE_GROUPS = 4
MOE_EPG = 4
MOE_TOP_K = 2
D_EXPERT = 512

kernel_name = 'hybrid_sgu_swa_dilated_hmoe_encoder'


def rms_norm(x, g):
    xf = x.astype(jnp.float32)
    y = xf * lax.rsqrt(jnp.mean(xf * xf, axis=-1, keepdims=True) + EPS)
    return (y * g.astype(jnp.float32)).astype(x.dtype)


def layer_norm(x, g, b):
    xf = x.astype(jnp.float32)
    mu = jnp.mean(xf, axis=-1, keepdims=True)
    var = jnp.mean(jnp.square(xf - mu), axis=-1, keepdims=True)
    y = (xf - mu) * lax.rsqrt(var + EPS)
    return (y * g.astype(jnp.float32) + b.astype(jnp.float32)).astype(x.dtype)


def t5_bucket(rel):
    nb = REL_BUCKETS // 2
    max_exact = nb // 2
    ret = jnp.where(rel > 0, nb, 0)
    n = jnp.abs(rel)
    nf = jnp.maximum(n, 1).astype(jnp.float32)
    large = max_exact + (jnp.log(nf / max_exact) / math.log(REL_MAX_DIST / max_exact)
                         * (nb - max_exact)).astype(jnp.int32)
    large = jnp.minimum(large, nb - 1)
    return ret + jnp.where(n < max_exact, n, large)


def rel_bias(table, rel):
    return jnp.moveaxis(table[t5_bucket(rel)], -1, 0).astype(jnp.float32)


def band_rel(block):
    return jnp.arange(3 * block)[None, :] - block - jnp.arange(block)[:, None]


def banded_attention(q, k, v, half, block, bias, sink=None):
    n, L, kvh, g, e = q.shape
    nb = -(-L // block)
    pad = nb * block - L
    qb = jnp.pad(q, ((0, 0), (0, pad), (0, 0), (0, 0), (0, 0))).reshape(n, nb, block, kvh, g, e)

    def windows(t):
        tp = jnp.pad(t, ((0, 0), (block, block + pad), (0, 0), (0, 0))).reshape(n, nb + 2, block, kvh, e)
        return jnp.concatenate([tp[:, :-2], tp[:, 1:-1], tp[:, 2:]], axis=2)

    kw = windows(k)
    vw = windows(v)
    qpos = jnp.arange(nb * block).reshape(nb, block)
    kpos = jnp.arange(nb)[:, None] * block - block + jnp.arange(3 * block)[None, :]
    rel = kpos[:, None, :] - qpos[:, :, None]
    valid = (jnp.abs(rel) <= half) & (kpos[:, None, :] >= 0) & (kpos[:, None, :] < L)
    logits = jnp.einsum('nbqkge,nbjke->nbkgqj', qb, kw).astype(jnp.float32) * (e ** -0.5)
    logits = logits + bias[None, None]
    logits = jnp.where(valid[None, :, None, None], logits, NEG_INF)
    m = jnp.max(logits, axis=-1)
    if sink is not None:
        s = jnp.broadcast_to(sink.astype(jnp.float32)[None, None, :, :, None], m.shape)
        m = jnp.maximum(m, s)
    p = jnp.exp(logits - m[..., None])
    den = jnp.sum(p, axis=-1)
    if sink is not None:
        den = den + jnp.exp(s - m)
    out = jnp.einsum('nbkgqj,nbjke->nbqkge', p, vw.astype(jnp.float32))
    out = out / jnp.moveaxis(den, -1, 2)[..., None]
    out = out.reshape(n, nb * block, kvh, g, e)[:, :L].astype(q.dtype)
    lse = jnp.moveaxis(m + jnp.log(den), -1, 2).reshape(n, nb * block, kvh, g)[:, :L]
    return out, lse


def spatial_gating(u, v, ln_g, ln_b, w_s, b_s):
    bsz, s, _ = v.shape
    vn = layer_norm(v, ln_g, ln_b).reshape(bsz, s // A_CHUNK, A_CHUNK, A_GROUPS, A_CH)
    mixed = jnp.einsum('gpq,bnqgc->bnpgc', w_s, vn) + jnp.transpose(b_s)[None, None, :, :, None]
    return u * mixed.reshape(bsz, s, A_WIDTH).astype(u.dtype)


def even_mixer(h, w_in, w_out, ln_g, ln_b, w_s, b_s, sink, table):
    bsz, s, _ = h.shape
    z = h @ w_in
    u, va, q, k, v = jnp.split(z, [A_WIDTH, 2 * A_WIDTH, 2 * A_WIDTH + B_WIDTH,
                                   2 * A_WIDTH + B_WIDTH + B_KV_WIDTH], axis=-1)
    ya = spatial_gating(jax.nn.gelu(u), jax.nn.gelu(va), ln_g, ln_b, w_s, b_s)
    q = q.reshape(bsz, s, B_KV_HEADS, B_Q_PER_KV, B_HEAD_DIM)
    k = k.reshape(bsz, s, B_KV_HEADS, B_HEAD_DIM)
    v = v.reshape(bsz, s, B_KV_HEADS, B_HEAD_DIM)
    bias = rel_bias(table, band_rel(B_BLOCK)).reshape(B_KV_HEADS, B_Q_PER_KV, B_BLOCK, 3 * B_BLOCK)
    yb, _ = banded_attention(q, k, v, B_HALF_WINDOW, B_BLOCK, bias,
                             sink.reshape(B_KV_HEADS, B_Q_PER_KV))
    yb = yb.reshape(bsz, s, B_WIDTH)
    return jnp.concatenate([ya, yb], axis=-1) @ w_out


def odd_mixer(h, w_in, w_out, table):
    bsz, s, _ = h.shape
    z = (h @ w_in).reshape(bsz, s, C_GROUPS, 3, C_HEADS, C_HEAD_DIM)
    outs = []
    lses = []
    for gi, (window, dil) in enumerate(C_PAIRS):
        half = window // 2 // dil
        length = s // dil

        def strided(t):
            return t.reshape(bsz, length, dil, C_HEADS, C_HEAD_DIM).transpose(0, 2, 1, 3, 4).reshape(
                bsz * dil, length, C_HEADS, C_HEAD_DIM)

        qs = strided(z[:, :, gi, 0])[:, :, :, None]
        bias = rel_bias(table, band_rel(C_BLOCK) * dil)[:, None]
        o, lse = banded_attention(qs, strided(z[:, :, gi, 1]), strided(z[:, :, gi, 2]), half, C_BLOCK, bias)
        o = o[:, :, :, 0].reshape(bsz, dil, length, C_HEADS, C_HEAD_DIM).transpose(0, 2, 1, 3, 4)
        outs.append(o.reshape(bsz, s, C_HEADS, C_HEAD_DIM))
        lse = lse[..., 0].reshape(bsz, dil, length, C_HEADS).transpose(0, 2, 1, 3)
        lses.append(lse.reshape(bsz, s, C_HEADS))
    wts = jax.nn.softmax(jnp.stack(lses, axis=0), axis=0)
    y = jnp.einsum('gbsh,gbshe->bshe', wts, jnp.stack(outs, axis=0).astype(jnp.float32))
    return y.reshape(bsz, s, C_WIDTH).astype(h.dtype) @ w_out


def cross_attention(h, mem_n, wq, wkv, wo):
    bsz, s, _ = h.shape
    q = (h @ wq).reshape(bsz, s, X_HEADS, X_HEAD_DIM)
    kv = (mem_n @ wkv).reshape(bsz, mem_n.shape[1], 2, X_HEADS, X_HEAD_DIM)
    logits = jnp.einsum('bshe,bmhe->bhsm', q, kv[:, :, 0]).astype(jnp.float32) * (X_HEAD_DIM ** -0.5)
    p = jax.nn.softmax(logits, axis=-1)
    o = jnp.einsum('bhsm,bmhe->bshe', p, kv[:, :, 1].astype(jnp.float32)).astype(h.dtype)
    return o.reshape(bsz, s, X_WIDTH) @ wo


def hier_moe(h, w_grp, b_grp, w_exp, b_exp, w_gate, w_up, w_down):
    bsz, s, d = h.shape
    t = h.reshape(-1, d)
    g_logits = (t @ w_grp).astype(jnp.float32) + b_grp.astype(jnp.float32)
    g_prob = jax.nn.softmax(g_logits, axis=-1)
    grp = jnp.argmax(g_logits, axis=-1)
    g_gate = jnp.take_along_axis(g_prob, grp[:, None], axis=-1)
    e_logits = jnp.einsum('td,dge->tge', t, w_exp).astype(jnp.float32) + b_exp.astype(jnp.float32)
    e_sel = jnp.take_along_axis(e_logits, grp[:, None, None], axis=1)[:, 0]
    top_v, top_i = lax.top_k(e_sel, MOE_TOP_K)
    top_w = jax.nn.softmax(top_v, axis=-1)
    within = jnp.sum(jax.nn.one_hot(top_i, MOE_EPG, dtype=jnp.float32) * top_w[..., None], axis=1)
    gate = jax.nn.one_hot(grp, MOE_GROUPS, dtype=jnp.float32)[:, :, None] * (g_gate * within)[:, None, :]
    y = jnp.zeros((t.shape[0], d), jnp.float32)
    for gi in range(MOE_GROUPS):
        hid = jax.nn.silu(jnp.einsum('td,edf->tef', t, w_gate[gi])) * jnp.einsum('td,edf->tef', t, w_up[gi])
        hid = hid * gate[:, gi, :, None]
        y = y + jnp.einsum('tef,efd->td', hid, w_down[gi])
    return y.reshape(bsz, s, d).astype(h.dtype)


def setup_inputs(seed: int = 0) -> dict:
    key = jax.random.key(seed)
    ks = jax.random.split(key, 27)
    f32 = jnp.float32

    def nrm(k, shape, scale):
        return jax.random.normal(k, shape, f32) * scale

    def gain(k, shape):
        return 1.0 + 0.02 * jax.random.normal(k, shape, f32)

    d = D_MODEL
    return {
        'x': nrm(ks[0], (BATCH, SEQ, d), 1.0),
        'mem': nrm(ks[1], (BATCH, MEM_LEN, d), 1.0),
        'ln_mix': gain(ks[2], (DEPTH, d)),
        'ln_cross': gain(ks[3], (DEPTH, d)),
        'ln_mem': gain(ks[4], (DEPTH, d)),
        'ln_ffn': gain(ks[5], (DEPTH, d)),
        'ln_final': gain(ks[6], (d,)),
        'rel_table': nrm(ks[7], (REL_BUCKETS, REL_HEADS), 0.5),
        'even_w_in': nrm(ks[8], (N_EVEN, d, EVEN_IN), d ** -0.5),
        'even_w_out': nrm(ks[9], (N_EVEN, EVEN_OUT, d), EVEN_OUT ** -0.5),
        'sgu_ln_g': gain(ks[10], (N_EVEN, A_WIDTH)),
        'sgu_ln_b': nrm(ks[11], (N_EVEN, A_WIDTH), 0.02),
        'sgu_w': nrm(ks[12], (N_EVEN, A_GROUPS, A_CHUNK, A_CHUNK), A_CHUNK ** -0.5),
        'sgu_b': 1.0 + nrm(ks[13], (N_EVEN, A_GROUPS, A_CHUNK), 0.02),
        'attn_sink': nrm(ks[14], (N_EVEN, B_HEADS), 0.5),
        'odd_w_in': nrm(ks[15], (N_ODD, d, ODD_IN), d ** -0.5),
        'odd_w_out': nrm(ks[16], (N_ODD, C_WIDTH, d), C_WIDTH ** -0.5),
        'xq_w': nrm(ks[17], (DEPTH, d, X_WIDTH), d ** -0.5),
        'xkv_w': nrm(ks[18], (DEPTH, d, 2 * X_WIDTH), d ** -0.5),
        'xo_w': nrm(ks[19], (DEPTH, X_WIDTH, d), X_WIDTH ** -0.5),
        'router_group_w': nrm(ks[20], (DEPTH, d, MOE_GROUPS), d ** -0.5),
        'router_group_b': nrm(ks[21], (DEPTH, MOE_GROUPS), 0.01),
        'router_expert_w': nrm(ks[22], (DEPTH, d, MOE_GROUPS, MOE_EPG), d ** -0.5),
        'router_expert_b': nrm(ks[23], (DEPTH, MOE_GROUPS, MOE_EPG), 0.01),
        'expert_w_gate': nrm(ks[24], (DEPTH, MOE_GROUPS, MOE_EPG, d, D_EXPERT), d ** -0.5),
        'expert_w_up': nrm(ks[25], (DEPTH, MOE_GROUPS, MOE_EPG, d, D_EXPERT), d ** -0.5),
        'expert_w_down': nrm(ks[26], (DEPTH, MOE_GROUPS, MOE_EPG, D_EXPERT, d), D_EXPERT ** -0.5),
    }


def reference(x, mem, ln_mix, ln_cross, ln_mem, ln_ffn, ln_final, rel_table,
              even_w_in, even_w_out, sgu_ln_g, sgu_ln_b, sgu_w, sgu_b, attn_sink,
              odd_w_in, odd_w_out, xq_w, xkv_w, xo_w,
              router_group_w, router_group_b, router_expert_w, router_expert_b,
              expert_w_gate, expert_w_up, expert_w_down):
    h = x
    for layer in range(DEPTH):
        i = layer // 2
        n = rms_norm(h, ln_mix[layer])
        if layer % 2 == 0:
            mix = even_mixer(n, even_w_in[i], even_w_out[i], sgu_ln_g[i], sgu_ln_b[i],
                             sgu_w[i], sgu_b[i], attn_sink[i], rel_table)
        else:
            mix = odd_mixer(n, odd_w_in[i], odd_w_out[i], rel_table)
        h = h + mix.astype(h.dtype)
        mem_n = rms_norm(mem, ln_mem[layer])
        h = h + cross_attention(rms_norm(h, ln_cross[layer]), mem_n, xq_w[layer], xkv_w[layer], xo_w[layer])
        h = h + hier_moe(rms_norm(h, ln_ffn[layer]), router_group_w[layer], router_group_b[layer],
                         router_expert_w[layer], router_expert_b[layer],
                         expert_w_gate[layer], expert_w_up[layer], expert_w_down[layer])
    return rms_norm(h, ln_final)
```

```cpp
#include <hip/hip_runtime.h>
#include <cstdio>
#include <cstdint>

typedef unsigned short bf16;
#define LAS __attribute__((address_space(3)))

constexpr int S = 16384, D = 1024, DEPTH = 4, MEM = 256;
constexpr int EVEN_IN = 1792, ODD_IN = 9216;
constexpr int NT = 512;
constexpr size_t MiB = 1u << 20;
constexpr size_t WS_CTL = 0;
constexpr size_t WS_H = 1 * MiB;
constexpr size_t WS_N = 65 * MiB;
constexpr size_t WS_Z = 129 * MiB;
constexpr size_t WS_Y = 417 * MiB;
constexpr size_t WS_VN = 481 * MiB;
constexpr size_t WS_MISC = 513 * MiB;
constexpr size_t MISC_BTE = 0;
constexpr size_t MISC_BTO = 16384;
constexpr size_t MISC_MEMN = 1 * MiB;
constexpr size_t MISC_KV = 5 * MiB;
constexpr size_t MISC_LIST = 9 * MiB;
constexpr size_t MISC_GW = 11 * MiB;
constexpr size_t WS_END = 525 * MiB;
constexpr size_t Z_QX = 0;
constexpr size_t Z_OX = 32 * MiB;
constexpr size_t Z_HID = 64 * MiB;
constexpr size_t Z_YS = 128 * MiB;
constexpr int CW_CNT = 1024;

struct Params {
    const float *x, *mem, *ln_mix, *ln_cross, *ln_mem, *ln_ffn, *ln_final, *rel_table,
        *even_w_in, *even_w_out, *sgu_ln_g, *sgu_ln_b, *sgu_w, *sgu_b, *attn_sink,
        *odd_w_in, *odd_w_out, *xq_w, *xkv_w, *xo_w, *rgw, *rgb, *rew, *reb, *ewg, *ewu, *ewd;
    float* out;
    unsigned char* ws;
};

__device__ __forceinline__ float bf2f(bf16 b) { return __uint_as_float(((unsigned)b) << 16); }
__device__ __forceinline__ bf16 f2bf(float f) { unsigned u = __float_as_uint(f); u += 0x7fffu + ((u >> 16) & 1u); return (bf16)(u >> 16); }
__device__ __forceinline__ float wave_sum(float v) {
#pragma unroll
    for (int o = 1; o < 64; o <<= 1) v += __shfl_xor(v, o);
    return v;
}
__device__ __forceinline__ float gelu_tanh(float x) {
    const float u = 0.7978845608028654f * (x + 0.044715f * x * x * x);
    return 0.5f * x * (1.0f + tanhf(u));
}
__device__ __forceinline__ int t5_bucket(int rel) {
    const int ret = rel > 0 ? 16 : 0;
    const int n = rel < 0 ? -rel : rel;
    if (n < 8) return ret + n;
    const float nf = (float)n;
    int large = 8 + (int)(logf(nf / 8.0f) / 4.852030263919617f * 8.0f);
    large = large < 15 ? large : 15;
    return ret + large;
}

template <class AF, class EF>
__device__ __forceinline__ void ngemm(float* sm, int M, int N, int K, const float* B, int ldb, AF af, EF ef) {
    float* As = sm;
    float* Bs = sm + 16 * 132;
    const int tid = threadIdx.x, tx = tid & 15, ty = tid >> 4;
    const int ntm = (M + 127) / 128, ntn = N / 64;
    for (int t = blockIdx.x; t < ntm * ntn; t += gridDim.x) {
        const int tm = t / ntn, tn = t % ntn;
        float acc[4][4];
#pragma unroll
        for (int i = 0; i < 4; ++i)
#pragma unroll
            for (int j = 0; j < 4; ++j) acc[i][j] = 0.f;
        for (int k0 = 0; k0 < K; k0 += 16) {
#pragma unroll
            for (int i = 0; i < 4; ++i) { const int idx = tid + i * 512, r = idx >> 4, kk = idx & 15, row = tm * 128 + r; As[kk * 132 + r] = row < M ? af(row, k0 + kk) : 0.f; }
#pragma unroll
            for (int i = 0; i < 2; ++i) { const int idx = tid + i * 512, kk = idx >> 6, c = idx & 63; Bs[kk * 64 + c] = B[(size_t)(k0 + kk) * ldb + tn * 64 + c]; }
            __syncthreads();
#pragma unroll
            for (int kk = 0; kk < 16; ++kk) {
                const float4 a = *(const float4*)(As + kk * 132 + ty * 4);
                const float4 b = *(const float4*)(Bs + kk * 64 + tx * 4);
                const float av[4] = {a.x, a.y, a.z, a.w}, bv[4] = {b.x, b.y, b.z, b.w};
#pragma unroll
                for (int i = 0; i < 4; ++i)
#pragma unroll
                    for (int j = 0; j < 4; ++j) acc[i][j] += av[i] * bv[j];
            }
            __syncthreads();
        }
#pragma unroll
        for (int i = 0; i < 4; ++i) { const int row = tm * 128 + ty * 4 + i; if (row < M) {
#pragma unroll
            for (int j = 0; j < 4; ++j) ef(row, tn * 64 + tx * 4 + j, acc[i][j]); } }
    }
}

enum Phase { PH_INIT = 0, PH_MEMKV, PH_NORM_MIX, PH_GEMM1, PH_SGU1, PH_SGU2, PH_WATT, PH_DATT, PH_GEMM2, PH_NORM_X, PH_GEMM3, PH_XATT, PH_GEMM4, PH_NORM_F, PH_ROUTE, PH_MOE1A, PH_MOE1B, PH_MOE2, PH_FIN, PH_OUT };

__device__ __forceinline__ void rmsnorm_rows(const float* src, const float* g, float* dst, int rows) {
    const int lane = threadIdx.x & 63, gw = blockIdx.x * (NT / 64) + (threadIdx.x >> 6), NGW = gridDim.x * (NT / 64);
    for (int r = gw; r < rows; r += NGW) {
        const float4* s4 = (const float4*)(src + (size_t)r * D);
        float4 v[4]; float ss = 0.f;
#pragma unroll
        for (int j = 0; j < 4; ++j) { v[j] = s4[lane + 64 * j]; ss += v[j].x * v[j].x + v[j].y * v[j].y + v[j].z * v[j].z + v[j].w * v[j].w; }
        const float rs = rsqrtf(wave_sum(ss) * (1.0f / D) + 1e-6f);
        float4* d4 = (float4*)(dst + (size_t)r * D);
#pragma unroll
        for (int j = 0; j < 4; ++j) { const float4 gg = ((const float4*)g)[lane + 64 * j]; float4 o; o.x = v[j].x * rs * gg.x; o.y = v[j].y * rs * gg.y; o.z = v[j].z * rs * gg.z; o.w = v[j].w * rs * gg.w; d4[lane + 64 * j] = o; }
    }
}

template <int PH>
__device__ __forceinline__ void run_phase(const Params& p, int layer, float* sm) {
    unsigned char* ws = p.ws;
    float* h = (float*)(ws + WS_H); float* nb = (float*)(ws + WS_N); bf16* z = (bf16*)(ws + WS_Z); float* y = (float*)(ws + WS_Y); float* vn = (float*)(ws + WS_VN);
    float* bte = (float*)(ws + WS_MISC + MISC_BTE); float* bto = (float*)(ws + WS_MISC + MISC_BTO);
    float* memn = (float*)(ws + WS_MISC + MISC_MEMN); float* kvm = (float*)(ws + WS_MISC + MISC_KV);
    int* lists = (int*)(ws + WS_MISC + MISC_LIST); float* gatew = (float*)(ws + WS_MISC + MISC_GW);
    float* qx = (float*)(ws + WS_Z + Z_QX); float* ox = (float*)(ws + WS_Z + Z_OX); float* hid = (float*)(ws + WS_Z + Z_HID); float* ys = (float*)(ws + WS_Z + Z_YS);
    unsigned* ctl = (unsigned*)(ws + WS_CTL);
    const int tid = threadIdx.x, lane = tid & 63, wv = tid >> 6;
    const int gtid = blockIdx.x * NT + tid, GT = gridDim.x * NT;
    const int gw = blockIdx.x * (NT / 64) + wv, NGW = gridDim.x * (NT / 64);
    const int il = layer >> 1;
    const bool even = (layer & 1) == 0;

    if constexpr (PH == PH_INIT) {
        for (size_t i = gtid; i < (size_t)S * D / 4; i += GT) ((float4*)h)[i] = ((const float4*)p.x)[i];
        for (int i = gtid; i < 8 * 257; i += GT) { const int hh = i / 257, rel = i % 257 - 128; bte[i] = p.rel_table[t5_bucket(rel) * 8 + hh]; }
        for (int i = gtid; i < 3 * 8 * 129; i += GT) { const int g = i / (8 * 129), hh = (i / 129) % 8, j = i % 129 - 64; const int dil = g == 0 ? 1 : (g == 1 ? 4 : 16); bto[i] = p.rel_table[t5_bucket(j * dil) * 8 + hh]; }
        for (int l = 0; l < DEPTH; ++l) rmsnorm_rows(p.mem, p.ln_mem + l * D, memn + (size_t)l * MEM * D, MEM);
    }
    if constexpr (PH == PH_MEMKV) {
        for (int l = 0; l < DEPTH; ++l) {
            const float* A = memn + (size_t)l * MEM * D; float* C = kvm + (size_t)l * MEM * 1024;
            ngemm(sm, MEM, 1024, D, p.xkv_w + (size_t)l * D * 1024, 1024, [&](int r, int k) { return A[(size_t)r * D + k]; }, [&](int r, int c, float v) { C[(size_t)r * 1024 + c] = v; });
        }
    }
    if constexpr (PH == PH_NORM_MIX) rmsnorm_rows(h, p.ln_mix + layer * D, nb, S);
    if constexpr (PH == PH_NORM_X) rmsnorm_rows(h, p.ln_cross + layer * D, nb, S);
    if constexpr (PH == PH_NORM_F) rmsnorm_rows(h, p.ln_ffn + layer * D, nb, S);
    if constexpr (PH == PH_GEMM1) {
        const int N = even ? EVEN_IN : ODD_IN;
        const float* W = even ? p.even_w_in + (size_t)il * D * EVEN_IN : p.odd_w_in + (size_t)il * D * ODD_IN;
        ngemm(sm, S, N, D, W, N, [&](int r, int k) { return nb[(size_t)r * D + k]; }, [&](int r, int c, float v) { z[(size_t)r * N + c] = f2bf(v); });
    }
    if constexpr (PH == PH_SGU1) {
        const float* lg = p.sgu_ln_g + il * 512; const float* lb = p.sgu_ln_b + il * 512;
        for (int t = gw; t < S; t += NGW) {
            float v[8]; float s = 0.f;
#pragma unroll
            for (int j = 0; j < 8; ++j) { v[j] = gelu_tanh(bf2f(z[(size_t)t * EVEN_IN + 512 + lane + 64 * j])); s += v[j]; }
            const float mu = wave_sum(s) * (1.f / 512.f); float q = 0.f;
#pragma unroll
            for (int j = 0; j < 8; ++j) { v[j] -= mu; q += v[j] * v[j]; }
            const float rstd = rsqrtf(wave_sum(q) * (1.f / 512.f) + 1e-6f);
#pragma unroll
            for (int j = 0; j < 8; ++j) { const int c = lane + 64 * j; vn[(size_t)t * 512 + c] = v[j] * rstd * lg[c] + lb[c]; }
        }
    }
    if constexpr (PH == PH_SGU2) {
        const float* wsg = p.sgu_w + (size_t)il * 4 * 128 * 128; const float* bs = p.sgu_b + il * 4 * 128;
        for (size_t i = gtid; i < (size_t)S * 512; i += GT) {
            const int t = (int)(i >> 9), ch = (int)(i & 511), g = ch >> 7, pp = t & 127, n0 = t & ~127;
            const float* wr = wsg + ((size_t)g * 128 + pp) * 128; float acc = 0.f;
            for (int q = 0; q < 128; ++q) acc += wr[q] * vn[(size_t)(n0 + q) * 512 + ch];
            acc += bs[g * 128 + pp];
            y[(size_t)t * D + ch] = gelu_tanh(bf2f(z[(size_t)t * EVEN_IN + ch])) * acc;
        }
    }
    if constexpr (PH == PH_WATT) {
        const float* sink = p.attn_sink + il * 8;
        for (int it = gw; it < S * 8; it += NGW) {
            const int pos = it >> 3, hh = it & 7, kv = hh >> 2;
            const float q = bf2f(z[(size_t)pos * EVEN_IN + 1024 + hh * 64 + lane]);
            float m = sink[hh], den = 1.f, acc = 0.f;
            const int j0 = pos - 128 < 0 ? 0 : pos - 128, j1 = pos + 128 > S - 1 ? S - 1 : pos + 128;
            for (int j = j0; j <= j1; ++j) {
                const float kk = bf2f(z[(size_t)j * EVEN_IN + 1536 + kv * 64 + lane]);
                const float vv = bf2f(z[(size_t)j * EVEN_IN + 1664 + kv * 64 + lane]);
                const float sc = wave_sum(q * kk) * 0.125f + bte[hh * 257 + (j - pos + 128)];
                const float mn = fmaxf(m, sc), a = __expf(m - mn), pr = __expf(sc - mn);
                den = den * a + pr; acc = acc * a + pr * vv; m = mn;
            }
            y[(size_t)pos * D + 512 + hh * 64 + lane] = acc / den;
        }
    }
    if constexpr (PH == PH_DATT) {
        for (int it = gw; it < S * 8; it += NGW) {
            const int pos = it >> 3, hh = it & 7;
            float m = -1e30f, den = 0.f, a0 = 0.f, a1 = 0.f;
            for (int g = 0; g < 3; ++g) {
                const int dil = g == 0 ? 1 : (g == 1 ? 4 : 16);
                const bf16* zq = z + (size_t)pos * ODD_IN + g * 3072 + hh * 128;
                const float q0 = bf2f(zq[lane]), q1 = bf2f(zq[lane + 64]);
                for (int j = -64; j <= 64; ++j) {
                    const int kp = pos + j * dil; if (kp < 0 || kp >= S) continue;
                    const bf16* zk = z + (size_t)kp * ODD_IN + g * 3072 + 1024 + hh * 128; const bf16* zv = zk + 1024;
                    const float sc = wave_sum(q0 * bf2f(zk[lane]) + q1 * bf2f(zk[lane + 64])) * 0.08838834764831845f + bto[(g * 8 + hh) * 129 + j + 64];
                    const float mn = fmaxf(m, sc), a = __expf(m - mn), pr = __expf(sc - mn);
                    den = den * a + pr; a0 = a0 * a + pr * bf2f(zv[lane]); a1 = a1 * a + pr * bf2f(zv[lane + 64]); m = mn;
                }
            }
            y[(size_t)pos * D + hh * 128 + lane] = a0 / den; y[(size_t)pos * D + hh * 128 + lane + 64] = a1 / den;
        }
    }
    if constexpr (PH == PH_GEMM2) {
        const float* W = even ? p.even_w_out + (size_t)il * D * D : p.odd_w_out + (size_t)il * D * D;
        ngemm(sm, S, D, D, W, D, [&](int r, int k) { return y[(size_t)r * D + k]; }, [&](int r, int c, float v) { h[(size_t)r * D + c] += v; });
    }
    if constexpr (PH == PH_GEMM3) {
        ngemm(sm, S, 512, D, p.xq_w + (size_t)layer * D * 512, 512, [&](int r, int k) { return nb[(size_t)r * D + k]; }, [&](int r, int c, float v) { qx[(size_t)r * 512 + c] = v; });
    }
    if constexpr (PH == PH_XATT) {
        const float* kvl = kvm + (size_t)layer * MEM * 1024;
        for (int it = gw; it < S * 4; it += NGW) {
            const int pos = it >> 2, hh = it & 3;
            const float q0 = qx[(size_t)pos * 512 + hh * 128 + lane], q1 = qx[(size_t)pos * 512 + hh * 128 + lane + 64];
            float m = -1e30f, den = 0.f, a0 = 0.f, a1 = 0.f;
            for (int j = 0; j < MEM; ++j) {
                const float* kr = kvl + (size_t)j * 1024 + hh * 128; const float* vr = kr + 512;
                const float sc = wave_sum(q0 * kr[lane] + q1 * kr[lane + 64]) * 0.08838834764831845f;
                const float mn = fmaxf(m, sc), a = __expf(m - mn), pr = __expf(sc - mn);
                den = den * a + pr; a0 = a0 * a + pr * vr[lane]; a1 = a1 * a + pr * vr[lane + 64]; m = mn;
            }
            ox[(size_t)pos * 512 + hh * 128 + lane] = a0 / den; ox[(size_t)pos * 512 + hh * 128 + lane + 64] = a1 / den;
        }
    }
    if constexpr (PH == PH_GEMM4) {
        ngemm(sm, S, D, 512, p.xo_w + (size_t)layer * 512 * D, D, [&](int r, int k) { return ox[(size_t)r * 512 + k]; }, [&](int r, int c, float v) { h[(size_t)r * D + c] += v; });
    }
    if constexpr (PH == PH_ROUTE) {
        const float* wg = p.rgw + (size_t)layer * D * 4; const float* we = p.rew + (size_t)layer * D * 16;
        const float* bg = p.rgb + layer * 4; const float* be = p.reb + layer * 16;
        for (int t = gw; t < S; t += NGW) {
            float lg[4], le[16];
#pragma unroll
            for (int c = 0; c < 4; ++c) lg[c] = 0.f;
#pragma unroll
            for (int c = 0; c < 16; ++c) le[c] = 0.f;
            for (int k = lane; k < D; k += 64) {
                const float xv = nb[(size_t)t * D + k];
                const float4 g4 = *(const float4*)(wg + (size_t)k * 4);
                lg[0] += xv * g4.x; lg[1] += xv * g4.y; lg[2] += xv * g4.z; lg[3] += xv * g4.w;
#pragma unroll
                for (int c4 = 0; c4 < 4; ++c4) { const float4 e4 = *(const float4*)(we + (size_t)k * 16 + c4 * 4); le[c4 * 4 + 0] += xv * e4.x; le[c4 * 4 + 1] += xv * e4.y; le[c4 * 4 + 2] += xv * e4.z; le[c4 * 4 + 3] += xv * e4.w; }
            }
#pragma unroll
            for (int c = 0; c < 4; ++c) lg[c] = wave_sum(lg[c]) + bg[c];
#pragma unroll
            for (int c = 0; c < 16; ++c) le[c] = wave_sum(le[c]) + be[c];
            if (lane == 0) {
                int grp = 0; float gm = lg[0];
#pragma unroll
                for (int c = 1; c < 4; ++c) if (lg[c] > gm) { gm = lg[c]; grp = c; }
                float gs = 0.f;
#pragma unroll
                for (int c = 0; c < 4; ++c) gs += __expf(lg[c] - gm);
                const float ggate = 1.0f / gs;
                float es[4];
#pragma unroll
                for (int e = 0; e < 4; ++e) es[e] = grp == 0 ? le[e] : (grp == 1 ? le[4 + e] : (grp == 2 ? le[8 + e] : le[12 + e]));
                int i0 = 0; float v0 = es[0];
#pragma unroll
                for (int e = 1; e < 4; ++e) if (es[e] > v0) { v0 = es[e]; i0 = e; }
                int i1 = -1; float v1 = -3.0e38f;
#pragma unroll
                for (int e = 0; e < 4; ++e) if (e != i0 && es[e] > v1) { v1 = es[e]; i1 = e; }
                const float ex = __expf(v1 - v0); const float w0 = 1.0f / (1.0f + ex), w1 = ex / (1.0f + ex);
                const int E0 = grp * 4 + i0, E1 = grp * 4 + i1;
                const unsigned p0 = atomicAdd(&ctl[CW_CNT + (layer * 16 + E0) * 64], 1u);
                const unsigned p1 = atomicAdd(&ctl[CW_CNT + (layer * 16 + E1) * 64], 1u);
                lists[E0 * 32768 + p0] = 2 * t; lists[E1 * 32768 + p1] = 2 * t + 1;
                gatew[2 * t] = ggate * w0; gatew[2 * t + 1] = ggate * w1;
            }
        }
    }
    if constexpr (PH == PH_MOE1A || PH == PH_MOE1B) {
        for (int e = 0; e < 16; ++e) {
            const int M = (int)ctl[CW_CNT + (layer * 16 + e) * 64]; const int* le = lists + e * 32768;
            const float* W = (PH == PH_MOE1A ? p.ewg : p.ewu) + ((size_t)layer * 16 + e) * D * 512;
            ngemm(sm, M, 512, D, W, 512, [&](int r, int k) { return nb[(size_t)(le[r] >> 1) * D + k]; },
                  [&](int r, int c, float v) { const int sl = le[r]; float* o = hid + (size_t)sl * 512 + c;
                      if (PH == PH_MOE1A) *o = v; else { const float g = *o; *o = g / (1.0f + __expf(-g)) * v * gatew[sl]; } });
        }
    }
    if constexpr (PH == PH_MOE2) {
        for (int e = 0; e < 16; ++e) {
            const int M = (int)ctl[CW_CNT + (layer * 16 + e) * 64]; const int* le = lists + e * 32768;
            const float* W = p.ewd + ((size_t)layer * 16 + e) * 512 * D;
            ngemm(sm, M, D, 512, W, D, [&](int r, int k) { return hid[(size_t)le[r] * 512 + k]; }, [&](int r, int c, float v) { ys[(size_t)le[r] * D + c] = v; });
        }
    }
    if constexpr (PH == PH_FIN) {
        for (size_t i = gtid; i < (size_t)S * D / 4; i += GT) {
            const size_t t = i >> 8, c = i & 255;
            float4 a = ((float4*)h)[i]; const float4 b = ((const float4*)ys)[(2 * t) * 256 + c], d = ((const float4*)ys)[(2 * t + 1) * 256 + c];
            a.x += b.x + d.x; a.y += b.y + d.y; a.z += b.z + d.z; a.w += b.w + d.w; ((float4*)h)[i] = a;
        }
    }
    if constexpr (PH == PH_OUT) rmsnorm_rows(h, p.ln_final, p.out, S);
}

template <int PH>
__global__ void __launch_bounds__(NT, 2) k_phase(Params p, int layer) {
    __shared__ float sm[16 * 132 + 16 * 64];
    run_phase<PH>(p, layer, sm);
}

extern "C" void kernel_launch(void* const* d_in, const int* in_sizes, int n_in, void* d_out, int out_size, void* d_ws, size_t ws_size, hipStream_t stream) {
    if (n_in != 27 || ws_size < WS_END) { fprintf(stderr, "kernel_launch: unexpected n_in %d or ws_size %zu\n", n_in, ws_size); return; }
    Params p{};
    const float** pp = (const float**)&p;
    for (int i = 0; i < 27; ++i) pp[i] = (const float*)d_in[i];
    p.out = (float*)d_out; p.ws = (unsigned char*)d_ws;
    hipMemsetAsync((char*)d_ws + WS_CTL, 0, 1 * MiB, stream);
    const int G = 1024;
#define L(PH, layer) hipLaunchKernelGGL(k_phase<PH>, dim3(G), dim3(NT), 0, stream, p, layer)
    L(PH_INIT, 0); L(PH_MEMKV, 0);
    for (int l = 0; l < DEPTH; ++l) {
        L(PH_NORM_MIX, l); L(PH_GEMM1, l);
        if ((l & 1) == 0) { L(PH_SGU1, l); L(PH_SGU2, l); L(PH_WATT, l); } else { L(PH_DATT, l); }
        L(PH_GEMM2, l); L(PH_NORM_X, l); L(PH_GEMM3, l); L(PH_XATT, l); L(PH_GEMM4, l);
        L(PH_NORM_F, l); L(PH_ROUTE, l); L(PH_MOE1A, l); L(PH_MOE1B, l); L(PH_MOE2, l); L(PH_FIN, l);
    }
    L(PH_OUT, 0);
#undef L
}
```

```cpp
#include <hip/hip_runtime.h>
#include <cstdio>
#include <cstdint>

typedef unsigned short bf16;
#define LAS __attribute__((address_space(3)))

constexpr int S = 16384, D = 1024, DEPTH = 4, MEM = 256;
constexpr int EVEN_IN = 1792, ODD_IN = 9216;
constexpr int NT = 512;
constexpr size_t MiB = 1u << 20;
constexpr size_t WS_CTL = 0;
constexpr size_t WS_H = 1 * MiB;
constexpr size_t WS_N = 65 * MiB;
constexpr size_t WS_Z = 129 * MiB;
constexpr size_t WS_Y = 417 * MiB;
constexpr size_t WS_VN = 481 * MiB;
constexpr size_t WS_MISC = 513 * MiB;
constexpr size_t MISC_BTE = 0;
constexpr size_t MISC_BTO = 16384;
constexpr size_t MISC_MEMN = 1 * MiB;
constexpr size_t MISC_KV = 5 * MiB;
constexpr size_t MISC_LIST = 9 * MiB;
constexpr size_t MISC_GW = 11 * MiB;
constexpr size_t WS_END = 525 * MiB;
constexpr size_t Z_QX = 0;
constexpr size_t Z_OX = 32 * MiB;
constexpr size_t Z_HID = 64 * MiB;
constexpr size_t Z_YS = 128 * MiB;
constexpr int CW_CNT = 1024;

struct Params {
    const float *x, *mem, *ln_mix, *ln_cross, *ln_mem, *ln_ffn, *ln_final, *rel_table,
        *even_w_in, *even_w_out, *sgu_ln_g, *sgu_ln_b, *sgu_w, *sgu_b, *attn_sink,
        *odd_w_in, *odd_w_out, *xq_w, *xkv_w, *xo_w, *rgw, *rgb, *rew, *reb, *ewg, *ewu, *ewd;
    float* out;
    unsigned char* ws;
};

__device__ __forceinline__ int otid() { int t = threadIdx.x; asm volatile("" : "+v"(t)); return t; }
__device__ __forceinline__ int obid() { int t = blockIdx.x; asm volatile("" : "+s"(t)); return t; }
__device__ __forceinline__ float bf2f(bf16 b) { return __uint_as_float(((unsigned)b) << 16); }
__device__ __forceinline__ bf16 f2bf(float f) { unsigned u = __float_as_uint(f); u += 0x7fffu + ((u >> 16) & 1u); return (bf16)(u >> 16); }
__device__ __forceinline__ float wave_sum(float v) {
#pragma unroll
    for (int o = 1; o < 64; o <<= 1) v += __shfl_xor(v, o);
    return v;
}
__device__ __forceinline__ float gelu_tanh(float x) {
    const float u = 0.7978845608028654f * (x + 0.044715f * x * x * x);
    return 0.5f * x * (1.0f + tanhf(u));
}
__device__ __forceinline__ int t5_bucket(int rel) {
    const int ret = rel > 0 ? 16 : 0;
    const int n = rel < 0 ? -rel : rel;
    if (n < 8) return ret + n;
    const float nf = (float)n;
    int large = 8 + (int)(logf(nf / 8.0f) / 4.852030263919617f * 8.0f);
    large = large < 15 ? large : 15;
    return ret + large;
}

template <class AF, class EF>
__device__ __forceinline__ void ngemm(float* sm, int M, int N, int K, const float* B, int ldb, AF af, EF ef) {
    float* As = sm;
    float* Bs = sm + 16 * 132;
    const int tid = otid(), tx = tid & 15, ty = tid >> 4;
    const int ntm = (M + 127) / 128, ntn = N / 64;
    for (int t = obid(); t < ntm * ntn; t += gridDim.x) {
        const int tm = t / ntn, tn = t % ntn;
        float acc[4][4];
#pragma unroll
        for (int i = 0; i < 4; ++i)
#pragma unroll
            for (int j = 0; j < 4; ++j) acc[i][j] = 0.f;
        for (int k0 = 0; k0 < K; k0 += 16) {
#pragma unroll
            for (int i = 0; i < 4; ++i) { const int idx = tid + i * 512, r = idx >> 4, kk = idx & 15, row = tm * 128 + r; As[kk * 132 + r] = row < M ? af(row, k0 + kk) : 0.f; }
#pragma unroll
            for (int i = 0; i < 2; ++i) { const int idx = tid + i * 512, kk = idx >> 6, c = idx & 63; Bs[kk * 64 + c] = B[(size_t)(k0 + kk) * ldb + tn * 64 + c]; }
            __syncthreads();
#pragma unroll
            for (int kk = 0; kk < 16; ++kk) {
                const float4 a = *(const float4*)(As + kk * 132 + ty * 4);
                const float4 b = *(const float4*)(Bs + kk * 64 + tx * 4);
                const float av[4] = {a.x, a.y, a.z, a.w}, bv[4] = {b.x, b.y, b.z, b.w};
#pragma unroll
                for (int i = 0; i < 4; ++i)
#pragma unroll
                    for (int j = 0; j < 4; ++j) acc[i][j] += av[i] * bv[j];
            }
            __syncthreads();
        }
#pragma unroll
        for (int i = 0; i < 4; ++i) { const int row = tm * 128 + ty * 4 + i; if (row < M) {
#pragma unroll
            for (int j = 0; j < 4; ++j) ef(row, tn * 64 + tx * 4 + j, acc[i][j]); } }
    }
}

enum Phase { PH_INIT = 0, PH_MEMKV, PH_NORM_MIX, PH_GEMM1, PH_SGU1, PH_SGU2, PH_WATT, PH_DATT, PH_GEMM2, PH_NORM_X, PH_GEMM3, PH_XATT, PH_GEMM4, PH_NORM_F, PH_ROUTE, PH_MOE1A, PH_MOE1B, PH_MOE2, PH_FIN, PH_OUT };

__device__ __forceinline__ void rmsnorm_rows(const float* src, const float* g, float* dst, int rows) {
    const int tid_ = otid(); const int lane = tid_ & 63, gw = obid() * (NT / 64) + (tid_ >> 6), NGW = gridDim.x * (NT / 64);
    for (int r = gw; r < rows; r += NGW) {
        const float4* s4 = (const float4*)(src + (size_t)r * D);
        float4 v[4]; float ss = 0.f;
#pragma unroll
        for (int j = 0; j < 4; ++j) { v[j] = s4[lane + 64 * j]; ss += v[j].x * v[j].x + v[j].y * v[j].y + v[j].z * v[j].z + v[j].w * v[j].w; }
        const float rs = rsqrtf(wave_sum(ss) * (1.0f / D) + 1e-6f);
        float4* d4 = (float4*)(dst + (size_t)r * D);
#pragma unroll
        for (int j = 0; j < 4; ++j) { const float4 gg = ((const float4*)g)[lane + 64 * j]; float4 o; o.x = v[j].x * rs * gg.x; o.y = v[j].y * rs * gg.y; o.z = v[j].z * rs * gg.z; o.w = v[j].w * rs * gg.w; d4[lane + 64 * j] = o; }
    }
}

template <int PH>
__device__ __forceinline__ void run_phase(const Params& p, int layer, float* sm) {
    unsigned char* ws = p.ws;
    asm volatile("" : "+s"(ws), "+s"(layer));
    float* h = (float*)(ws + WS_H); float* nb = (float*)(ws + WS_N); bf16* z = (bf16*)(ws + WS_Z); float* y = (float*)(ws + WS_Y); float* vn = (float*)(ws + WS_VN);
    float* bte = (float*)(ws + WS_MISC + MISC_BTE); float* bto = (float*)(ws + WS_MISC + MISC_BTO);
    float* memn = (float*)(ws + WS_MISC + MISC_MEMN); float* kvm = (float*)(ws + WS_MISC + MISC_KV);
    int* lists = (int*)(ws + WS_MISC + MISC_LIST); float* gatew = (float*)(ws + WS_MISC + MISC_GW);
    float* qx = (float*)(ws + WS_Z + Z_QX); float* ox = (float*)(ws + WS_Z + Z_OX); float* hid = (float*)(ws + WS_Z + Z_HID); float* ys = (float*)(ws + WS_Z + Z_YS);
    unsigned* ctl = (unsigned*)(ws + WS_CTL);
    const int tid = otid(), lane = tid & 63, wv = tid >> 6; const int bid = obid();
    const int gtid = bid * NT + tid, GT = gridDim.x * NT;
    const int gw = bid * (NT / 64) + wv, NGW = gridDim.x * (NT / 64);
    const int il = layer >> 1;
    const bool even = (layer & 1) == 0;

    if constexpr (PH == PH_INIT) {
        for (size_t i = gtid; i < (size_t)S * D / 4; i += GT) ((float4*)h)[i] = ((const float4*)p.x)[i];
        for (int i = gtid; i < 8 * 257; i += GT) { const int hh = i / 257, rel = i % 257 - 128; bte[i] = p.rel_table[t5_bucket(rel) * 8 + hh]; }
        for (int i = gtid; i < 3 * 8 * 129; i += GT) { const int g = i / (8 * 129), hh = (i / 129) % 8, j = i % 129 - 64; const int dil = g == 0 ? 1 : (g == 1 ? 4 : 16); bto[i] = p.rel_table[t5_bucket(j * dil) * 8 + hh]; }
        for (int l = 0; l < DEPTH; ++l) rmsnorm_rows(p.mem, p.ln_mem + l * D, memn + (size_t)l * MEM * D, MEM);
    }
    if constexpr (PH == PH_MEMKV) {
        for (int l = 0; l < DEPTH; ++l) {
            const float* A = memn + (size_t)l * MEM * D; float* C = kvm + (size_t)l * MEM * 1024;
            ngemm(sm, MEM, 1024, D, p.xkv_w + (size_t)l * D * 1024, 1024, [&](int r, int k) { return A[(size_t)r * D + k]; }, [&](int r, int c, float v) { C[(size_t)r * 1024 + c] = v; });
        }
    }
    if constexpr (PH == PH_NORM_MIX) rmsnorm_rows(h, p.ln_mix + layer * D, nb, S);
    if constexpr (PH == PH_NORM_X) rmsnorm_rows(h, p.ln_cross + layer * D, nb, S);
    if constexpr (PH == PH_NORM_F) rmsnorm_rows(h, p.ln_ffn + layer * D, nb, S);
    if constexpr (PH == PH_GEMM1) {
        const int N = even ? EVEN_IN : ODD_IN;
        const float* W = even ? p.even_w_in + (size_t)il * D * EVEN_IN : p.odd_w_in + (size_t)il * D * ODD_IN;
        ngemm(sm, S, N, D, W, N, [&](int r, int k) { return nb[(size_t)r * D + k]; }, [&](int r, int c, float v) { z[(size_t)r * N + c] = f2bf(v); });
    }
    if constexpr (PH == PH_SGU1) {
        const float* lg = p.sgu_ln_g + il * 512; const float* lb = p.sgu_ln_b + il * 512;
        for (int t = gw; t < S; t += NGW) {
            float v[8]; float s = 0.f;
#pragma unroll
            for (int j = 0; j < 8; ++j) { v[j] = gelu_tanh(bf2f(z[(size_t)t * EVEN_IN + 512 + lane + 64 * j])); s += v[j]; }
            const float mu = wave_sum(s) * (1.f / 512.f); float q = 0.f;
#pragma unroll
            for (int j = 0; j < 8; ++j) { v[j] -= mu; q += v[j] * v[j]; }
            const float rstd = rsqrtf(wave_sum(q) * (1.f / 512.f) + 1e-6f);
#pragma unroll
            for (int j = 0; j < 8; ++j) { const int c = lane + 64 * j; vn[(size_t)t * 512 + c] = v[j] * rstd * lg[c] + lb[c]; }
        }
    }
    if constexpr (PH == PH_SGU2) {
        const float* wsg = p.sgu_w + (size_t)il * 4 * 128 * 128; const float* bs = p.sgu_b + il * 4 * 128;
        for (size_t i = gtid; i < (size_t)S * 512; i += GT) {
            const int t = (int)(i >> 9), ch = (int)(i & 511), g = ch >> 7, pp = t & 127, n0 = t & ~127;
            const float* wr = wsg + ((size_t)g * 128 + pp) * 128; float acc = 0.f;
            for (int q = 0; q < 128; ++q) acc += wr[q] * vn[(size_t)(n0 + q) * 512 + ch];
            acc += bs[g * 128 + pp];
            y[(size_t)t * D + ch] = gelu_tanh(bf2f(z[(size_t)t * EVEN_IN + ch])) * acc;
        }
    }
    if constexpr (PH == PH_WATT) {
        const float* sink = p.attn_sink + il * 8;
        for (int it = gw; it < S * 8; it += NGW) {
            const int pos = it >> 3, hh = it & 7, kv = hh >> 2;
            const float q = bf2f(z[(size_t)pos * EVEN_IN + 1024 + hh * 64 + lane]);
            float m = sink[hh], den = 1.f, acc = 0.f;
            const int j0 = pos - 128 < 0 ? 0 : pos - 128, j1 = pos + 128 > S - 1 ? S - 1 : pos + 128;
            for (int j = j0; j <= j1; ++j) {
                const float kk = bf2f(z[(size_t)j * EVEN_IN + 1536 + kv * 64 + lane]);
                const float vv = bf2f(z[(size_t)j * EVEN_IN + 1664 + kv * 64 + lane]);
                const float sc = wave_sum(q * kk) * 0.125f + bte[hh * 257 + (j - pos + 128)];
                const float mn = fmaxf(m, sc), a = __expf(m - mn), pr = __expf(sc - mn);
                den = den * a + pr; acc = acc * a + pr * vv; m = mn;
            }
            y[(size_t)pos * D + 512 + hh * 64 + lane] = acc / den;
        }
    }
    if constexpr (PH == PH_DATT) {
        for (int it = gw; it < S * 8; it += NGW) {
            const int pos = it >> 3, hh = it & 7;
            float m = -1e30f, den = 0.f, a0 = 0.f, a1 = 0.f;
            for (int g = 0; g < 3; ++g) {
                const int dil = g == 0 ? 1 : (g == 1 ? 4 : 16);
                const bf16* zq = z + (size_t)pos * ODD_IN + g * 3072 + hh * 128;
                const float q0 = bf2f(zq[lane]), q1 = bf2f(zq[lane + 64]);
                for (int j = -64; j <= 64; ++j) {
                    const int kp = pos + j * dil; if (kp < 0 || kp >= S) continue;
                    const bf16* zk = z + (size_t)kp * ODD_IN + g * 3072 + 1024 + hh * 128; const bf16* zv = zk + 1024;
                    const float sc = wave_sum(q0 * bf2f(zk[lane]) + q1 * bf2f(zk[lane + 64])) * 0.08838834764831845f + bto[(g * 8 + hh) * 129 + j + 64];
                    const float mn = fmaxf(m, sc), a = __expf(m - mn), pr = __expf(sc - mn);
                    den = den * a + pr; a0 = a0 * a + pr * bf2f(zv[lane]); a1 = a1 * a + pr * bf2f(zv[lane + 64]); m = mn;
                }
            }
            y[(size_t)pos * D + hh * 128 + lane] = a0 / den; y[(size_t)pos * D + hh * 128 + lane + 64] = a1 / den;
        }
    }
    if constexpr (PH == PH_GEMM2) {
        const float* W = even ? p.even_w_out + (size_t)il * D * D : p.odd_w_out + (size_t)il * D * D;
        ngemm(sm, S, D, D, W, D, [&](int r, int k) { return y[(size_t)r * D + k]; }, [&](int r, int c, float v) { h[(size_t)r * D + c] += v; });
    }
    if constexpr (PH == PH_GEMM3) {
        ngemm(sm, S, 512, D, p.xq_w + (size_t)layer * D * 512, 512, [&](int r, int k) { return nb[(size_t)r * D + k]; }, [&](int r, int c, float v) { qx[(size_t)r * 512 + c] = v; });
    }
    if constexpr (PH == PH_XATT) {
        const float* kvl = kvm + (size_t)layer * MEM * 1024;
        for (int it = gw; it < S * 4; it += NGW) {
            const int pos = it >> 2, hh = it & 3;
            const float q0 = qx[(size_t)pos * 512 + hh * 128 + lane], q1 = qx[(size_t)pos * 512 + hh * 128 + lane + 64];
            float m = -1e30f, den = 0.f, a0 = 0.f, a1 = 0.f;
            for (int j = 0; j < MEM; ++j) {
                const float* kr = kvl + (size_t)j * 1024 + hh * 128; const float* vr = kr + 512;
                const float sc = wave_sum(q0 * kr[lane] + q1 * kr[lane + 64]) * 0.08838834764831845f;
                const float mn = fmaxf(m, sc), a = __expf(m - mn), pr = __expf(sc - mn);
                den = den * a + pr; a0 = a0 * a + pr * vr[lane]; a1 = a1 * a + pr * vr[lane + 64]; m = mn;
            }
            ox[(size_t)pos * 512 + hh * 128 + lane] = a0 / den; ox[(size_t)pos * 512 + hh * 128 + lane + 64] = a1 / den;
        }
    }
    if constexpr (PH == PH_GEMM4) {
        ngemm(sm, S, D, 512, p.xo_w + (size_t)layer * 512 * D, D, [&](int r, int k) { return ox[(size_t)r * 512 + k]; }, [&](int r, int c, float v) { h[(size_t)r * D + c] += v; });
    }
    if constexpr (PH == PH_ROUTE) {
        const float* wg = p.rgw + (size_t)layer * D * 4; const float* we = p.rew + (size_t)layer * D * 16;
        const float* bg = p.rgb + layer * 4; const float* be = p.reb + layer * 16;
        for (int t = gw; t < S; t += NGW) {
            float lg[4], le[16];
#pragma unroll
            for (int c = 0; c < 4; ++c) lg[c] = 0.f;
#pragma unroll
            for (int c = 0; c < 16; ++c) le[c] = 0.f;
            for (int k = lane; k < D; k += 64) {
                const float xv = nb[(size_t)t * D + k];
                const float4 g4 = *(const float4*)(wg + (size_t)k * 4);
                lg[0] += xv * g4.x; lg[1] += xv * g4.y; lg[2] += xv * g4.z; lg[3] += xv * g4.w;
#pragma unroll
                for (int c4 = 0; c4 < 4; ++c4) { const float4 e4 = *(const float4*)(we + (size_t)k * 16 + c4 * 4); le[c4 * 4 + 0] += xv * e4.x; le[c4 * 4 + 1] += xv * e4.y; le[c4 * 4 + 2] += xv * e4.z; le[c4 * 4 + 3] += xv * e4.w; }
            }
#pragma unroll
            for (int c = 0; c < 4; ++c) lg[c] = wave_sum(lg[c]) + bg[c];
#pragma unroll
            for (int c = 0; c < 16; ++c) le[c] = wave_sum(le[c]) + be[c];
            if (lane == 0) {
                int grp = 0; float gm = lg[0];
#pragma unroll
                for (int c = 1; c < 4; ++c) if (lg[c] > gm) { gm = lg[c]; grp = c; }
                float gs = 0.f;
#pragma unroll
                for (int c = 0; c < 4; ++c) gs += __expf(lg[c] - gm);
                const float ggate = 1.0f / gs;
                float es[4];
#pragma unroll
                for (int e = 0; e < 4; ++e) es[e] = grp == 0 ? le[e] : (grp == 1 ? le[4 + e] : (grp == 2 ? le[8 + e] : le[12 + e]));
                int i0 = 0; float v0 = es[0];
#pragma unroll
                for (int e = 1; e < 4; ++e) if (es[e] > v0) { v0 = es[e]; i0 = e; }
                int i1 = -1; float v1 = -3.0e38f;
#pragma unroll
                for (int e = 0; e < 4; ++e) if (e != i0 && es[e] > v1) { v1 = es[e]; i1 = e; }
                const float ex = __expf(v1 - v0); const float w0 = 1.0f / (1.0f + ex), w1 = ex / (1.0f + ex);
                const int E0 = grp * 4 + i0, E1 = grp * 4 + i1;
                const unsigned p0 = atomicAdd(&ctl[CW_CNT + (layer * 16 + E0) * 64], 1u);
                const unsigned p1 = atomicAdd(&ctl[CW_CNT + (layer * 16 + E1) * 64], 1u);
                lists[E0 * 32768 + p0] = 2 * t; lists[E1 * 32768 + p1] = 2 * t + 1;
                gatew[2 * t] = ggate * w0; gatew[2 * t + 1] = ggate * w1;
            }
        }
    }
    if constexpr (PH == PH_MOE1A || PH == PH_MOE1B) {
        for (int e = 0; e < 16; ++e) {
            const int M = (int)ctl[CW_CNT + (layer * 16 + e) * 64]; const int* le = lists + e * 32768;
            const float* W = (PH == PH_MOE1A ? p.ewg : p.ewu) + ((size_t)layer * 16 + e) * D * 512;
            ngemm(sm, M, 512, D, W, 512, [&](int r, int k) { return nb[(size_t)(le[r] >> 1) * D + k]; },
                  [&](int r, int c, float v) { const int sl = le[r]; float* o = hid + (size_t)sl * 512 + c;
                      if (PH == PH_MOE1A) *o = v; else { const float g = *o; *o = g / (1.0f + __expf(-g)) * v * gatew[sl]; } });
        }
    }
    if constexpr (PH == PH_MOE2) {
        for (int e = 0; e < 16; ++e) {
            const int M = (int)ctl[CW_CNT + (layer * 16 + e) * 64]; const int* le = lists + e * 32768;
            const float* W = p.ewd + ((size_t)layer * 16 + e) * 512 * D;
            ngemm(sm, M, D, 512, W, D, [&](int r, int k) { return hid[(size_t)le[r] * 512 + k]; }, [&](int r, int c, float v) { ys[(size_t)le[r] * D + c] = v; });
        }
    }
    if constexpr (PH == PH_FIN) {
        for (size_t i = gtid; i < (size_t)S * D / 4; i += GT) {
            const size_t t = i >> 8, c = i & 255;
            float4 a = ((float4*)h)[i]; const float4 b = ((const float4*)ys)[(2 * t) * 256 + c], d = ((const float4*)ys)[(2 * t + 1) * 256 + c];
            a.x += b.x + d.x; a.y += b.y + d.y; a.z += b.z + d.z; a.w += b.w + d.w; ((float4*)h)[i] = a;
        }
    }
    if constexpr (PH == PH_OUT) rmsnorm_rows(h, p.ln_final, p.out, S);
}


#define XB_TMO      128
#define XB_XCNT(j)  (256  + 64 * (j))
#define XB_XSUB(j)  (1280 + 64 * (j))
#define XB_XGEN(j)  (2304 + 64 * (j))
#define XB_TOP      3328
#define XB_TOPGEN   3392
#define XCD_BAR_WORDS 3456
#define XB_SPIN_CAP (1u << 22)
__device__ __forceinline__ unsigned xb_ld(unsigned* p)              { return __hip_atomic_load(p, __ATOMIC_RELAXED, __HIP_MEMORY_SCOPE_AGENT); }
__device__ __forceinline__ unsigned xb_add(unsigned* p, unsigned v) { return __hip_atomic_fetch_add(p, v, __ATOMIC_RELAXED, __HIP_MEMORY_SCOPE_AGENT); }
__device__ __forceinline__ unsigned xb_xcc_id() { return (unsigned)__builtin_amdgcn_s_getreg((3 << 11) | 20) & 0xFu; }
#define XB_SPIN(cond, bar) do { unsigned _sp = 0; while (cond) { __builtin_amdgcn_s_sleep(1); \
    if ((++_sp & 255u) == 0u) { if (xb_ld(&(bar)[XB_TMO])) break; if (_sp > XB_SPIN_CAP) { atomicAdd(&(bar)[XB_TMO], 1u); break; } } } } while (0)
struct XcdBarrier { unsigned* bar; unsigned x; volatile LAS unsigned* st; };
__device__ __forceinline__ XcdBarrier xcd_barrier_post(unsigned* bar, volatile LAS unsigned* st) {
    XcdBarrier b; b.bar = bar; b.x = xb_xcc_id(); b.st = st;
    if (threadIdx.x == 0) (void)xb_add(&bar[XB_XCNT(b.x)], 1u);
    return b;
}
__device__ __forceinline__ void xcd_barrier_complete(unsigned* bar, unsigned x, unsigned& nloc, unsigned& nx) {
    const unsigned G = gridDim.x * gridDim.y * gridDim.z;
    unsigned sum, cnt, mine, sp = 0u;
    for (;;) {
        sum = 0u; cnt = 0u; mine = 0u;
#pragma unroll
        for (unsigned j = 0; j < 16; ++j) { const unsigned c = xb_ld(&bar[XB_XCNT(j)]); sum += c; cnt += (c > 0u) ? 1u : 0u; mine = (j == x) ? c : mine; }
        if (sum == G) break;
        __builtin_amdgcn_s_sleep(1);
        if ((++sp & 255u) == 0u) { if (xb_ld(&bar[XB_TMO])) break; if (sp > XB_SPIN_CAP) { atomicAdd(&bar[XB_TMO], 1u); break; } }
    }
    nloc = mine > 0u ? mine : 1u; nx = cnt > 0u ? cnt : 1u;
}
__device__ __forceinline__ void xcd_barrier(const XcdBarrier& b) {
    asm volatile("s_waitcnt vmcnt(0)" ::: "memory");
    __syncthreads();
    if (threadIdx.x == 0) {
        unsigned* bar = b.bar;
        __builtin_amdgcn_s_waitcnt(0);
        unsigned nloc = b.st[0], nx = b.st[1];
        if (nloc == 0u) { xcd_barrier_complete(bar, b.x, nloc, nx); b.st[0] = nloc; b.st[1] = nx; }
        const unsigned old = xb_add(&bar[XB_XSUB(b.x)], 1u);
        const unsigned gen = old / nloc;
        if (old + 1u == (gen + 1u) * nloc) {
            __builtin_amdgcn_fence(__ATOMIC_RELEASE, "agent");
            asm volatile("s_waitcnt vmcnt(0)" ::: "memory");
            const unsigned og = xb_add(&bar[XB_TOP], 1u);
            const unsigned tg = og / nx;
            if (og + 1u == (tg + 1u) * nx) xb_add(&bar[XB_TOPGEN], 1u);
            else XB_SPIN(xb_ld(&bar[XB_TOPGEN]) == tg, bar);
            __builtin_amdgcn_fence(__ATOMIC_ACQUIRE, "agent");
            xb_add(&bar[XB_XGEN(b.x)], 1u);
            asm volatile("s_waitcnt vmcnt(0)" ::: "memory");
        } else {
            XB_SPIN(xb_ld(&bar[XB_XGEN(b.x)]) == gen, bar);
            __builtin_amdgcn_fence(__ATOMIC_ACQUIRE, "agent");
            asm volatile("s_waitcnt vmcnt(0)" ::: "memory");
        }
    }
    __syncthreads();
}
constexpr int CW_BAR = 8192;
constexpr int LDS_BYTES = 147456;
constexpr int LDS_BARW = 131072;

__global__ void __launch_bounds__(NT, 2) k_mega(Params p) {
    extern __shared__ __attribute__((aligned(16))) unsigned char lds[];
    float* sm = (float*)lds;
    if (threadIdx.x < 4) ((LAS unsigned*)((LAS unsigned char*)lds + LDS_BARW))[threadIdx.x] = 0u;
    __syncthreads();
    XcdBarrier bar = xcd_barrier_post((unsigned*)(p.ws + WS_CTL) + CW_BAR, (volatile LAS unsigned*)((LAS unsigned char*)lds + LDS_BARW));
#define PHB(PH, l) do { run_phase<PH>(p, l, sm); xcd_barrier(bar); } while (0)
    PHB(PH_INIT, 0); PHB(PH_MEMKV, 0);
    for (int l = 0; l < DEPTH; ++l) {
        PHB(PH_NORM_MIX, l); PHB(PH_GEMM1, l);
        if ((l & 1) == 0) { PHB(PH_SGU1, l); run_phase<PH_SGU2>(p, l, sm); PHB(PH_WATT, l); } else { PHB(PH_DATT, l); }
        PHB(PH_GEMM2, l); PHB(PH_NORM_X, l); PHB(PH_GEMM3, l); PHB(PH_XATT, l); PHB(PH_GEMM4, l);
        PHB(PH_NORM_F, l); PHB(PH_ROUTE, l); PHB(PH_MOE1A, l); PHB(PH_MOE1B, l); PHB(PH_MOE2, l); PHB(PH_FIN, l);
    }
    run_phase<PH_OUT>(p, 0, sm);
#undef PHB
}

template <int PH>
__global__ void __launch_bounds__(NT, 2) k_phase(Params p, int layer) {
    __shared__ float sm[16 * 132 + 16 * 64];
    run_phase<PH>(p, layer, sm);
}

extern "C" void kernel_launch(void* const* d_in, const int* in_sizes, int n_in, void* d_out, int out_size, void* d_ws, size_t ws_size, hipStream_t stream) {
    if (n_in != 27 || ws_size < WS_END) { fprintf(stderr, "kernel_launch: unexpected n_in %d or ws_size %zu\n", n_in, ws_size); return; }
    Params p{};
    const float** pp = (const float**)&p;
    for (int i = 0; i < 27; ++i) pp[i] = (const float*)d_in[i];
    p.out = (float*)d_out; p.ws = (unsigned char*)d_ws;
    (void)hipMemsetAsync((char*)d_ws + WS_CTL, 0, 1 * MiB, stream);
#ifdef MK_MULTI
    const int G = 1024;
#define L(PH, layer) hipLaunchKernelGGL(k_phase<PH>, dim3(G), dim3(NT), 0, stream, p, layer)
    L(PH_INIT, 0); L(PH_MEMKV, 0);
    for (int l = 0; l < DEPTH; ++l) {
        L(PH_NORM_MIX, l); L(PH_GEMM1, l);
        if ((l & 1) == 0) { L(PH_SGU1, l); L(PH_SGU2, l); L(PH_WATT, l); } else { L(PH_DATT, l); }
        L(PH_GEMM2, l); L(PH_NORM_X, l); L(PH_GEMM3, l); L(PH_XATT, l); L(PH_GEMM4, l);
        L(PH_NORM_F, l); L(PH_ROUTE, l); L(PH_MOE1A, l); L(PH_MOE1B, l); L(PH_MOE2, l); L(PH_FIN, l);
    }
    L(PH_OUT, 0);
#undef L
#else
    static int grid = 0;
    if (grid == 0) {
        int dev = 0, cus = 0, per_cu = 0;
        if (hipGetDevice(&dev) != hipSuccess || hipDeviceGetAttribute(&cus, hipDeviceAttributeMultiprocessorCount, dev) != hipSuccess) { grid = -1; return; }
        if (hipFuncSetAttribute((const void*)k_mega, hipFuncAttributeMaxDynamicSharedMemorySize, LDS_BYTES) != hipSuccess) { fprintf(stderr, "hipFuncSetAttribute failed\n"); grid = -1; return; }
        if (hipOccupancyMaxActiveBlocksPerMultiprocessor(&per_cu, (const void*)k_mega, NT, LDS_BYTES) != hipSuccess || per_cu < 1) { fprintf(stderr, "occupancy query: %d\n", per_cu); grid = -1; return; }
        (void)hipGetLastError();
        grid = cus;
    }
    if (grid < 0) return;
    hipLaunchKernelGGL(k_mega, dim3(grid), dim3(NT), LDS_BYTES, stream, p);
#endif
}
```

```cpp
#include <hip/hip_runtime.h>
#include <cstdio>
#include <cstdint>

typedef unsigned short bf16;
#define LAS __attribute__((address_space(3)))
typedef short bf16x8 __attribute__((ext_vector_type(8)));
typedef float f32x4 __attribute__((ext_vector_type(4)));
typedef float f32x16 __attribute__((ext_vector_type(16)));
typedef unsigned u32x4 __attribute__((ext_vector_type(4)));
typedef unsigned u32x2 __attribute__((ext_vector_type(2)));

constexpr int S = 16384, D = 1024, DEPTH = 4, MEM = 256;
constexpr int EVEN_IN = 1792, ODD_IN = 9216;
constexpr int NT = 512;
constexpr int LCAP = 16384;
constexpr size_t MiB = 1u << 20;
constexpr size_t WS_CTL = 0;
constexpr size_t WS_H = 1 * MiB;
constexpr size_t WS_HB = 65 * MiB;
constexpr size_t WS_Y = 97 * MiB;
constexpr size_t WS_Z = 129 * MiB;
constexpr size_t WS_WNX = 417 * MiB;
constexpr size_t WS_WEX = 484 * MiB;
constexpr size_t WS_MISC = 532 * MiB;
constexpr size_t WS_END = 548 * MiB;
constexpr size_t MISC_BTE = 0;
constexpr size_t MISC_BTO = 16384;
constexpr size_t MISC_SGW = 65536;
constexpr size_t MISC_MEMN = 1 * MiB;
constexpr size_t MISC_KV = 3 * MiB;
constexpr size_t MISC_LIST = 5 * MiB;
constexpr size_t MISC_GW = 6 * MiB;
constexpr size_t MISC_RSC = 6 * MiB + 131072;
constexpr size_t MISC_SSQ = 7 * MiB;
constexpr size_t MISC_LSE = 8 * MiB;
constexpr size_t Z_QX = 0;
constexpr size_t Z_OX = 16 * MiB;
constexpr size_t Z_HID = 32 * MiB;
constexpr size_t Z_VN = 64 * MiB;
constexpr size_t Z_YS = 96 * MiB;
constexpr size_t W1E_SZ = (size_t)EVEN_IN * D, W2_SZ = (size_t)D * D, W1O_SZ = (size_t)ODD_IN * D, WQ_SZ = (size_t)512 * D, WKV_SZ = (size_t)1024 * D, WO_SZ = (size_t)D * 512;
constexpr size_t WO_W1E = 0, WO_W2E = WO_W1E + 2 * W1E_SZ, WO_W1O = WO_W2E + 2 * W2_SZ, WO_W2O = WO_W1O + 2 * W1O_SZ, WO_WQ = WO_W2O + 2 * W2_SZ, WO_WKV = WO_WQ + 4 * WQ_SZ, WO_WO = WO_WKV + 4 * WKV_SZ, WO_END = WO_WO + 4 * WO_SZ;
static_assert(WO_END * 2 <= 67 * MiB, "non-expert weights fit");
constexpr size_t WGU_SZ = (size_t)1024 * 1024, WD_SZ = (size_t)1024 * 512;
constexpr size_t WEX_WD = 16 * WGU_SZ;
constexpr int CW_CNT = 1024;
constexpr int CW_BAR = 8192;
constexpr int LDS_BYTES = 147456;
constexpr int LDS_BARW = 131072;
constexpr int LDS_MOE = 131072 + 64;

struct Params {
    const float *x, *mem, *ln_mix, *ln_cross, *ln_mem, *ln_ffn, *ln_final, *rel_table,
        *even_w_in, *even_w_out, *sgu_ln_g, *sgu_ln_b, *sgu_w, *sgu_b, *attn_sink,
        *odd_w_in, *odd_w_out, *xq_w, *xkv_w, *xo_w, *rgw, *rgb, *rew, *reb, *ewg, *ewu, *ewd;
    float* out;
    unsigned char* ws;
};

__device__ __forceinline__ int otid() { int t = threadIdx.x; asm volatile("" : "+v"(t)); return t; }
__device__ __forceinline__ int obid() { int t = blockIdx.x; asm volatile("" : "+s"(t)); return t; }
__device__ __forceinline__ float bf2f(bf16 b) { return __uint_as_float(((unsigned)b) << 16); }
__device__ __forceinline__ bf16 f2bf(float f) { unsigned u = __float_as_uint(f); u += 0x7fffu + ((u >> 16) & 1u); return (bf16)(u >> 16); }
__device__ __forceinline__ unsigned cvt_pk_bf16(float lo, float hi) { unsigned r; asm volatile("v_cvt_pk_bf16_f32 %0, %1, %2" : "=v"(r) : "v"(lo), "v"(hi)); return r; }
__device__ __forceinline__ float wave_sum(float v) {
#pragma unroll
    for (int o = 1; o < 64; o <<= 1) v += __shfl_xor(v, o);
    return v;
}
__device__ __forceinline__ float gelu_tanh(float x) {
    const float u2 = 1.5957691216057308f * (x + 0.044715f * x * x * x);
    return x * __builtin_amdgcn_rcpf(1.0f + __expf(-u2));
}
__device__ __forceinline__ int t5_bucket(int rel) {
    const int ret = rel > 0 ? 16 : 0;
    const int n = rel < 0 ? -rel : rel;
    if (n < 8) return ret + n;
    const float nf = (float)n;
    int large = 8 + (int)(logf(nf / 8.0f) / 4.852030263919617f * 8.0f);
    large = large < 15 ? large : 15;
    return ret + large;
}

#define XB_TMO      128
#define XB_XCNT(j)  (256  + 64 * (j))
#define XB_XSUB(j)  (1280 + 64 * (j))
#define XB_XGEN(j)  (2304 + 64 * (j))
#define XB_TOP      3328
#define XB_TOPGEN   3392
#define XCD_BAR_WORDS 3456
#define XB_SPIN_CAP (1u << 22)
__device__ __forceinline__ unsigned xb_ld(unsigned* p)              { return __hip_atomic_load(p, __ATOMIC_RELAXED, __HIP_MEMORY_SCOPE_AGENT); }
__device__ __forceinline__ unsigned xb_add(unsigned* p, unsigned v) { return __hip_atomic_fetch_add(p, v, __ATOMIC_RELAXED, __HIP_MEMORY_SCOPE_AGENT); }
__device__ __forceinline__ unsigned xb_xcc_id() { return (unsigned)__builtin_amdgcn_s_getreg((3 << 11) | 20) & 0xFu; }
#define XB_SPIN(cond, bar) do { unsigned _sp = 0; while (cond) { __builtin_amdgcn_s_sleep(1); \
    if ((++_sp & 255u) == 0u) { if (xb_ld(&(bar)[XB_TMO])) break; if (_sp > XB_SPIN_CAP) { atomicAdd(&(bar)[XB_TMO], 1u); break; } } } } while (0)
struct XcdBarrier { unsigned* bar; unsigned x; volatile LAS unsigned* st; };
__device__ __forceinline__ XcdBarrier xcd_barrier_post(unsigned* bar, volatile LAS unsigned* st) {
    XcdBarrier b; b.bar = bar; b.x = (unsigned)__builtin_amdgcn_readfirstlane((int)xb_xcc_id()); b.st = st;
    if (threadIdx.x == 0) (void)xb_add(&bar[XB_XCNT(b.x)], 1u);
    return b;
}
__device__ __forceinline__ void xcd_barrier_complete(unsigned* bar, unsigned x, unsigned& nloc, unsigned& nx) {
    const unsigned G = gridDim.x * gridDim.y * gridDim.z;
    unsigned sum, cnt, mine, sp = 0u;
    for (;;) {
        sum = 0u; cnt = 0u; mine = 0u;
#pragma unroll
        for (unsigned j = 0; j < 16; ++j) { const unsigned c = xb_ld(&bar[XB_XCNT(j)]); sum += c; cnt += (c > 0u) ? 1u : 0u; mine = (j == x) ? c : mine; }
        if (sum == G) break;
        __builtin_amdgcn_s_sleep(1);
        if ((++sp & 255u) == 0u) { if (xb_ld(&bar[XB_TMO])) break; if (sp > XB_SPIN_CAP) { atomicAdd(&bar[XB_TMO], 1u); break; } }
    }
    nloc = mine > 0u ? mine : 1u; nx = cnt > 0u ? cnt : 1u;
}
__device__ __forceinline__ void xcd_barrier(const XcdBarrier& b) {
    asm volatile("s_waitcnt vmcnt(0)" ::: "memory");
    __syncthreads();
    if (threadIdx.x == 0) {
        unsigned* bar = b.bar; unsigned bx = b.x; asm volatile("" : "+s"(bar), "+s"(bx));
        __builtin_amdgcn_s_waitcnt(0);
        unsigned nloc = b.st[0], nx = b.st[1];
        if (nloc == 0u) { xcd_barrier_complete(bar, bx, nloc, nx); b.st[0] = nloc; b.st[1] = nx; }
        const unsigned old = xb_add(&bar[XB_XSUB(bx)], 1u);
        const unsigned gen = old / nloc;
        if (old + 1u == (gen + 1u) * nloc) {
            __builtin_amdgcn_fence(__ATOMIC_RELEASE, "agent");
            asm volatile("s_waitcnt vmcnt(0)" ::: "memory");
            const unsigned og = xb_add(&bar[XB_TOP], 1u);
            const unsigned tg = og / nx;
            if (og + 1u == (tg + 1u) * nx) xb_add(&bar[XB_TOPGEN], 1u);
            else XB_SPIN(xb_ld(&bar[XB_TOPGEN]) == tg, bar);
            __builtin_amdgcn_fence(__ATOMIC_ACQUIRE, "agent");
            xb_add(&bar[XB_XGEN(bx)], 1u);
            asm volatile("s_waitcnt vmcnt(0)" ::: "memory");
        } else {
            XB_SPIN(xb_ld(&bar[XB_XGEN(bx)]) == gen, bar);
            __builtin_amdgcn_fence(__ATOMIC_ACQUIRE, "agent");
            asm volatile("s_waitcnt vmcnt(0)" ::: "memory");
        }
    }
    __syncthreads();
}

namespace pg8 {
constexpr int BM = 256, BK = 64, HALF = 128, HTB = HALF * BK * 2, STAGE_BYTES = 8 * HTB, NXCD = 8, WGM = 8;
__host__ __device__ __forceinline__ int lds_byte(int r, int c) { const int st = (r >> 4) * 2 + (c >> 5), rr = r & 15, cc = c & 31, ob = rr * 64 + cc * 2; return st * 1024 + (ob ^ (((ob >> 9) & 1) << 5)); }
__host__ __device__ __forceinline__ void stage_rc(int b, int& R, int& C) { const int st = b / 1024, sb = b % 1024, swz = sb ^ (((sb >> 9) & 1) << 5); R = (st >> 1) * 16 + swz / 64; C = (st & 1) * 32 + (swz % 64) / 2; }
__host__ __device__ __forceinline__ int perm32(int rho) { const int n = rho >> 4, i = rho & 15; return 8 * (i >> 2) + 4 * n + (i & 3); }
struct Unit { int pm, pn, e, rows; };

struct DenseSched {
    int nM, nN, nwg, G, c, K; const bf16* Bt;
    __device__ void init(int M, int N, int K_, const bf16* Bt_, int G_, int c_) { nM = M / BM; nN = N / BM; nwg = nM * nN; G = G_; c = c_; K = K_; Bt = Bt_; }
    __device__ __forceinline__ bool next(int i, Unit& u) const {
        const long L = (long)i * G + c; if (L >= nwg) return false;
        int wgid = (int)L; { const int q = nwg / NXCD, r = nwg % NXCD, xcd = wgid % NXCD, off = wgid / NXCD; wgid = (xcd < r ? xcd * (q + 1) : r * (q + 1) + (xcd - r) * q) + off; }
        const int nig = WGM * nN, gid = wgid / nig, fm = gid * WGM, gsz = (nM - fm) < WGM ? (nM - fm) : WGM;
        u.pm = fm + ((wgid % nig) % gsz); u.pn = (wgid % nig) / gsz; u.e = 0; u.rows = 256; return true;
    }
    __device__ __forceinline__ unsigned arow(const Unit& u, int r) const { return (unsigned)(u.pm * BM + r) * (unsigned)(K * 2); }
    __device__ __forceinline__ const char* bbase(const Unit& u) const { return (const char*)Bt + (size_t)u.pn * BM * K * 2; }
};
template <bool TOKEN_ROWS>
struct MoeSched {
    int nN, G, c, K; const bf16* Bt; size_t bstride; const int* list; const LAS int* moe;
    __device__ __forceinline__ bool next(int i, Unit& u) const {
        const int L = i * G + c; const int total = moe[16] * nN; if (L >= total) return false;
        const int rt = L / nN; u.pn = L % nN; int e = 0;
#pragma unroll
        for (int j = 1; j < 16; ++j) e = (rt >= moe[j]) ? j : e;
        u.e = e; u.pm = rt - moe[e]; const int left = moe[17 + e] - u.pm * BM; u.rows = left < BM ? left : BM; return true;
    }
    __device__ __forceinline__ unsigned arow(const Unit& u, int r) const {
        const int idx = r < u.rows ? r : u.rows - 1; const int slot = list[u.e * LCAP + u.pm * BM + idx];
        return (unsigned)(TOKEN_ROWS ? (slot >> 1) : slot) * (unsigned)(K * 2);
    }
    __device__ __forceinline__ const char* bbase(const Unit& u) const { return (const char*)Bt + ((size_t)u.e * bstride + (size_t)u.pn * BM * K) * 2; }
};

template <class Epi, class Sched>
__device__ __forceinline__ void gemm_phase(LAS unsigned char* lds, const bf16* Abase, const int K, const Sched& S, const Epi& E) {
    const int tid = otid(), wid = __builtin_amdgcn_readfirstlane(tid >> 6), lane = tid & 63, wr = wid >> 2, wc = wid & 3, fr = lane & 15, fq = lane >> 4;
    const int nt = K / BK;
    unsigned voffB[2];
#pragma unroll
    for (int i = 0; i < 2; ++i) { int R, C; stage_rc(tid * 16 + i * 8192, R, C); const int Rb = Epi::PERM ? ((R & ~31) + perm32(R & 31)) : R;
        voffB[i] = (unsigned)(Rb * K + C) * 2u; }
#define PG8_AOFFS(u, o0, o1) do { const int _t = otid(); _Pragma("unroll") for (int _i = 0; _i < 2; ++_i) { int _R, _C; stage_rc(_t * 16 + _i * 8192, _R, _C); \
        o0[_i] = S.arow(u, _R) + (unsigned)_C * 2u; o1[_i] = S.arow(u, HALF + _R) + (unsigned)_C * 2u; } } while (0)
    const size_t kstep = (size_t)(BK * 2);
    const size_t hstep = (size_t)HALF * K * 2;
    const unsigned ldsw = (unsigned)wid * 1024u;
    const int aoff = lds_byte(wr * 64 + fr, fq * 8), boff = lds_byte(wc * 32 + fr, fq * 8);
    const char* Ab = (const char*)Abase;
#define PG8_SA(b, h) (((b) * 2 + (h)) * HTB)
#define PG8_SB(b, h) ((4 + (b) * 2 + (h)) * HTB)
#define PG8_STAGE(bufoff, gbase, voff) do { _Pragma("unroll") for (int _i = 0; _i < 2; ++_i) \
        __builtin_amdgcn_global_load_lds((const unsigned*)((const char*)(gbase) + (voff)[_i]), (LAS unsigned*)(lds + (bufoff) + ldsw + _i * 8192), 16, 0, 0); } while (0)
#define PG8_LDA(dst, b, h) do { _Pragma("unroll") for (int m = 0; m < 4; ++m) _Pragma("unroll") for (int k = 0; k < 2; ++k) dst[m][k] = *(const LAS bf16x8*)(lds + PG8_SA(b, h) + aoff + m * 2048 + k * 1024); } while (0)
#define PG8_LDB(dst, b, h) do { _Pragma("unroll") for (int n = 0; n < 2; ++n) _Pragma("unroll") for (int k = 0; k < 2; ++k) dst[n][k] = *(const LAS bf16x8*)(lds + PG8_SB(b, h) + boff + n * 2048 + k * 1024); } while (0)
#define PG8_MMA(ai, bj, At, Bt) do { __builtin_amdgcn_s_setprio(1); _Pragma("unroll") for (int m = 0; m < 4; ++m) _Pragma("unroll") for (int n = 0; n < 2; ++n) _Pragma("unroll") for (int k = 0; k < 2; ++k) \
        acc[ai][bj][m][n] = __builtin_amdgcn_mfma_f32_16x16x32_bf16(Bt[n][k], At[m][k], acc[ai][bj][m][n], 0, 0, 0); __builtin_amdgcn_s_setprio(0); } while (0)
#define PG8_WAIT_V(n) asm volatile("s_waitcnt vmcnt(" #n ")" ::: "memory")
#define PG8_WAIT_L(n) asm volatile("s_waitcnt lgkmcnt(" #n ")" ::: "memory")
#define PG8_BAR __builtin_amdgcn_s_barrier()
#define PG8_SCHED __builtin_amdgcn_sched_barrier(0)
    Unit cur, nxt; int ui = 0;
    if (!S.next(0, cur)) return;
    f32x4 acc[2][2][4][2];
#pragma unroll
    for (int a = 0; a < 2; ++a)
#pragma unroll
        for (int b = 0; b < 2; ++b)
#pragma unroll
            for (int m = 0; m < 4; ++m)
#pragma unroll
                for (int n = 0; n < 2; ++n) acc[a][b][m][n] = (f32x4){0.f, 0.f, 0.f, 0.f};
    bf16x8 At[4][2], B0[2][2], B1[2][2];
    unsigned oA0[2], oA1[2], oN0[2], oN1[2];
    PG8_AOFFS(cur, oA0, oA1);
    const char* cB = S.bbase(cur);
    PG8_STAGE(PG8_SB(0, 0), cB, voffB); PG8_STAGE(PG8_SB(0, 1), cB + hstep, voffB); PG8_STAGE(PG8_SA(0, 0), Ab, oA0); PG8_STAGE(PG8_SA(0, 1), Ab, oA1);
    if (wr == 1) PG8_BAR;
    PG8_WAIT_V(2); PG8_BAR;
    PG8_STAGE(PG8_SB(1, 0), cB + kstep, voffB); PG8_STAGE(PG8_SA(1, 0), Ab + kstep, oA0); PG8_STAGE(PG8_SB(1, 1), cB + hstep + kstep, voffB);
    PG8_WAIT_V(6); PG8_BAR;
    for (;;) {
        const bool has_next = S.next(ui + 1, nxt);
        const char* nB = has_next ? S.bbase(nxt) : cB;
        if (has_next) {
            PG8_AOFFS(nxt, oN0, oN1);
        } else {
#pragma unroll
            for (int i = 0; i < 2; ++i) { oN0[i] = oA0[i]; oN1[i] = oA1[i]; }
        }
        for (int t = 0; t < nt; t += 2) {
            const bool last = (t == nt - 2);
            const char* a1 = Ab + (size_t)(t + 1) * kstep;
            const char* a2 = last ? Ab : Ab + (size_t)(t + 2) * kstep; const char* b2 = last ? nB : cB + (size_t)(t + 2) * kstep;
            const char* a3 = a2 + kstep; const char* b3 = b2 + kstep;
            unsigned p0[2], p1[2];
#pragma unroll
            for (int i = 0; i < 2; ++i) { p0[i] = last ? oN0[i] : oA0[i]; p1[i] = last ? oN1[i] : oA1[i]; }
            PG8_LDB(B0, 0, 0); PG8_LDB(B1, 0, 1); PG8_SCHED; PG8_LDA(At, 0, 0); PG8_STAGE(PG8_SA(1, 1), a1, oA1);
            PG8_WAIT_V(8); PG8_WAIT_L(0); PG8_BAR; PG8_MMA(0, 0, At, B0); PG8_MMA(0, 1, At, B1); PG8_BAR; PG8_SCHED;
            PG8_LDA(At, 0, 1); PG8_STAGE(PG8_SB(0, 0), b2, voffB); PG8_STAGE(PG8_SB(0, 1), b2 + hstep, voffB); PG8_STAGE(PG8_SA(0, 0), a2, p0);
            PG8_WAIT_V(8); PG8_WAIT_L(0); PG8_BAR; PG8_MMA(1, 0, At, B0); PG8_MMA(1, 1, At, B1); PG8_BAR; PG8_SCHED;
            PG8_LDB(B0, 1, 0); PG8_LDB(B1, 1, 1); PG8_SCHED; PG8_LDA(At, 1, 0); PG8_STAGE(PG8_SA(0, 1), a2, p1);
            PG8_WAIT_V(8); PG8_WAIT_L(0); PG8_BAR; PG8_MMA(0, 0, At, B0); PG8_MMA(0, 1, At, B1); PG8_BAR; PG8_SCHED;
            PG8_LDA(At, 1, 1); PG8_STAGE(PG8_SB(1, 0), b3, voffB); PG8_STAGE(PG8_SB(1, 1), b3 + hstep, voffB); PG8_STAGE(PG8_SA(1, 0), a3, p0);
            PG8_WAIT_V(8); PG8_WAIT_L(0); PG8_BAR; PG8_MMA(1, 0, At, B0); PG8_MMA(1, 1, At, B1); PG8_BAR; PG8_SCHED;
        }
        if (wr == 0) PG8_BAR;
        E(acc, cur, wr, wc, fr, fq);
        if (!has_next) break;
#pragma unroll
        for (int a = 0; a < 2; ++a)
#pragma unroll
            for (int b = 0; b < 2; ++b)
#pragma unroll
                for (int m = 0; m < 4; ++m)
#pragma unroll
                    for (int n = 0; n < 2; ++n) acc[a][b][m][n] = (f32x4){0.f, 0.f, 0.f, 0.f};
        cur = nxt; cB = nB; ++ui;
#pragma unroll
        for (int i = 0; i < 2; ++i) { oA0[i] = oN0[i]; oA1[i] = oN1[i]; }
        if (wr == 1) PG8_BAR;
    }
    PG8_WAIT_V(0);
    PG8_BAR;
#undef PG8_AOFFS
#undef PG8_SA
#undef PG8_SB
#undef PG8_STAGE
#undef PG8_LDA
#undef PG8_LDB
#undef PG8_MMA
#undef PG8_WAIT_V
#undef PG8_WAIT_L
#undef PG8_BAR
#undef PG8_SCHED
}

__device__ __forceinline__ float row_rs(const float* ssqp, int row, int fq) {
    const f32x4 pp = *(const f32x4*)(ssqp + (size_t)row * 16 + 4 * fq);
    float s = (pp[0] + pp[1]) + (pp[2] + pp[3]);
    s += __shfl_xor(s, 16); s += __shfl_xor(s, 32);
    return rsqrtf(s * (1.0f / 1024.0f) + 1e-6f);
}
struct EpiScaleBf16 {
    static constexpr bool PERM = true;
    bf16* O; int ldc; const float* ssqp; int gelu_tiles;
    __device__ __forceinline__ void operator()(const f32x4 (&acc)[2][2][4][2], const Unit& u, int wr, int wc, int fr, int fq) const {
        const int row0 = u.pm * BM + wr * 64 + fr, col0 = u.pn * BM + wc * 32 + 8 * fq;
        const bool gl = u.pn < gelu_tiles;
#pragma unroll
        for (int ai = 0; ai < 2; ++ai)
#pragma unroll
            for (int m = 0; m < 4; ++m) {
                const int row = row0 + ai * HALF + m * 16;
                const float rs = ssqp ? row_rs(ssqp, row, fq) : 1.0f;
                bf16* rowp = O + (size_t)row * ldc + col0;
#pragma unroll
                for (int bj = 0; bj < 2; ++bj) {
                    f32x4 v0 = acc[ai][bj][m][0] * rs, v1 = acc[ai][bj][m][1] * rs;
                    if (gl) {
#pragma unroll
                        for (int j = 0; j < 4; ++j) { v0[j] = gelu_tanh(v0[j]); v1[j] = gelu_tanh(v1[j]); }
                    }
                    u32x4 w; w.x = cvt_pk_bf16(v0[0], v0[1]); w.y = cvt_pk_bf16(v0[2], v0[3]); w.z = cvt_pk_bf16(v1[0], v1[1]); w.w = cvt_pk_bf16(v1[2], v1[3]);
                    *(u32x4*)(rowp + bj * HALF) = w;
                }
            }
    }
};
struct EpiResidual {
    static constexpr bool PERM = false;
    const float* base; float* h; bf16* hb; float* ssqp;
    __device__ __forceinline__ void operator()(const f32x4 (&acc)[2][2][4][2], const Unit& u, int wr, int wc, int fr, int fq) const {
        const int row0 = u.pm * BM + wr * 64 + fr, col0 = u.pn * BM + wc * 32 + 4 * fq;
#pragma unroll
        for (int ai = 0; ai < 2; ++ai)
#pragma unroll
            for (int m = 0; m < 4; ++m) {
                const int row = row0 + ai * HALF + m * 16; const size_t off = (size_t)row * D + col0; float ss = 0.f;
#pragma unroll
                for (int bj = 0; bj < 2; ++bj)
#pragma unroll
                    for (int n = 0; n < 2; ++n) {
                        f32x4 hv = *(const f32x4*)(base + off + bj * HALF + n * 16); hv = hv + acc[ai][bj][m][n];
                        *(f32x4*)(h + off + bj * HALF + n * 16) = hv;
                        u32x2 w; w.x = cvt_pk_bf16(hv[0], hv[1]); w.y = cvt_pk_bf16(hv[2], hv[3]); *(u32x2*)(hb + off + bj * HALF + n * 16) = w;
                        ss += (hv[0] * hv[0] + hv[1] * hv[1]) + (hv[2] * hv[2] + hv[3] * hv[3]);
                    }
                ss += __shfl_xor(ss, 16); ss += __shfl_xor(ss, 32);
                if (fq == 0) ssqp[(size_t)row * 16 + u.pn * 4 + wc] = ss;
                asm volatile("" ::: "memory");
            }
    }
};
struct EpiMoe1 {
    static constexpr bool PERM = true;
    bf16* hid; const int* list; const float* rsc; const float* gatew;
    __device__ __forceinline__ void operator()(const f32x4 (&acc)[2][2][4][2], const Unit& u, int wr, int wc, int fr, int fq) const {
        const int f0 = u.pn * 128 + wc * 16 + 4 * fq;
#pragma unroll
        for (int ai = 0; ai < 2; ++ai)
#pragma unroll
            for (int m = 0; m < 4; ++m) {
                const int r = ai * HALF + wr * 64 + m * 16 + fr; const bool valid = r < u.rows;
                const int slot = list[u.e * LCAP + u.pm * BM + (valid ? r : u.rows - 1)];
                const float sc = rsc[slot], gw = gatew[slot];
#pragma unroll
                for (int bj = 0; bj < 2; ++bj) {
                    const f32x4 g = acc[ai][bj][m][0] * sc, up = acc[ai][bj][m][1] * sc; f32x4 o;
#pragma unroll
                    for (int j = 0; j < 4; ++j) o[j] = g[j] * __builtin_amdgcn_rcpf(1.0f + __expf(-g[j])) * up[j] * gw;
                    u32x2 w; w.x = cvt_pk_bf16(o[0], o[1]); w.y = cvt_pk_bf16(o[2], o[3]);
                    if (valid) *(u32x2*)(hid + (size_t)slot * 512 + f0 + bj * 64) = w;
                }
            }
    }
};
struct EpiMoe2 {
    static constexpr bool PERM = true;
    bf16* ys; const int* list;
    __device__ __forceinline__ void operator()(const f32x4 (&acc)[2][2][4][2], const Unit& u, int wr, int wc, int fr, int fq) const {
        const int col0 = u.pn * BM + wc * 32 + 8 * fq;
#pragma unroll
        for (int ai = 0; ai < 2; ++ai)
#pragma unroll
            for (int m = 0; m < 4; ++m) {
                const int r = ai * HALF + wr * 64 + m * 16 + fr; const bool valid = r < u.rows;
                const int slot = list[u.e * LCAP + u.pm * BM + (valid ? r : u.rows - 1)];
#pragma unroll
                for (int bj = 0; bj < 2; ++bj) {
                    const f32x4 v0 = acc[ai][bj][m][0], v1 = acc[ai][bj][m][1];
                    u32x4 w; w.x = cvt_pk_bf16(v0[0], v0[1]); w.y = cvt_pk_bf16(v0[2], v0[3]); w.z = cvt_pk_bf16(v1[0], v1[1]); w.w = cvt_pk_bf16(v1[2], v1[3]);
                    if (valid) *(u32x4*)(ys + (size_t)slot * D + col0 + bj * HALF) = w;
                }
            }
    }
};
}

template <class RM>
__device__ __forceinline__ void cvt_item(const float* W, int N, int K, const float* g, bf16* WT, RM rowmap, LAS float* scr, int kb, int nb, int lane) {
    const int k0 = 64 * kb, n0 = 32 * nb;
    float v[32];
#pragma unroll
    for (int i = 0; i < 32; ++i) { const int kk = 2 * i + (lane >> 5); v[i] = W[(size_t)(k0 + kk) * N + n0 + (lane & 31)]; }
    if (g) {
#pragma unroll
        for (int i = 0; i < 32; ++i) v[i] *= g[k0 + 2 * i + (lane >> 5)];
    }
#pragma unroll
    for (int i = 0; i < 32; ++i) { const int kk = 2 * i + (lane >> 5); scr[kk * 33 + (lane & 31)] = v[i]; }
    asm volatile("s_waitcnt lgkmcnt(0)" ::: "memory");
    const int c = lane & 7;
#pragma unroll
    for (int j = 0; j < 4; ++j) { const int n = (lane >> 3) + 8 * j; const LAS float* s = scr + (8 * c) * 33 + n;
        u32x4 o; o.x = cvt_pk_bf16(s[0 * 33], s[1 * 33]); o.y = cvt_pk_bf16(s[2 * 33], s[3 * 33]); o.z = cvt_pk_bf16(s[4 * 33], s[5 * 33]); o.w = cvt_pk_bf16(s[6 * 33], s[7 * 33]);
        *(u32x4*)(WT + (size_t)rowmap(n0 + n) * K + k0 + 8 * c) = o; }
    asm volatile("s_waitcnt lgkmcnt(0)" ::: "memory");
}
struct CvtCtx { int gw, NGW, base, lane; LAS float* scr; };
template <class RM>
__device__ __forceinline__ void cvt_matrix(CvtCtx& c, const float* W, int K, int N, const float* g, bf16* WT, RM rowmap) {
    const int nblk = N / 32, nitems = (K / 64) * nblk;
    int j0 = (c.gw - c.base) % c.NGW; if (j0 < 0) j0 += c.NGW;
    for (int j = j0; j < nitems; j += c.NGW) cvt_item(W, N, K, g, WT, rowmap, c.scr, j / nblk, j % nblk, c.lane);
    c.base = (c.base + nitems) % c.NGW;
}

__device__ __forceinline__ void rms_row_bf16(const float4 (&v)[4], float rs, const float* g, bf16* dst, int lane) {
#pragma unroll
    for (int j = 0; j < 4; ++j) { const float4 gg = g ? ((const float4*)g)[lane + 64 * j] : make_float4(1.f, 1.f, 1.f, 1.f);
        u32x2 w; w.x = cvt_pk_bf16(v[j].x * rs * gg.x, v[j].y * rs * gg.y); w.y = cvt_pk_bf16(v[j].z * rs * gg.z, v[j].w * rs * gg.w); ((u32x2*)dst)[lane + 64 * j] = w; }
}

enum Phase { PH_INIT = 0, PH_EXPCVT, PH_GEMM1, PH_SGU1, PH_SGU2, PH_WATT, PH_DATT, PH_GEMM2, PH_GEMM3, PH_XATT, PH_GEMM4, PH_ROUTE, PH_MOE1, PH_MOE2, PH_FIN };

template <int PH>
__device__ __forceinline__ void run_phase(const Params& p, int layer, LAS unsigned char* lds) {
    unsigned char* ws = p.ws;
    asm volatile("" : "+s"(ws), "+s"(layer));
    float* h = (float*)(ws + WS_H); bf16* hb = (bf16*)(ws + WS_HB); bf16* y = (bf16*)(ws + WS_Y); bf16* z = (bf16*)(ws + WS_Z);
    bf16* wnx = (bf16*)(ws + WS_WNX); bf16* wex = (bf16*)(ws + WS_WEX);
    float* bte = (float*)(ws + WS_MISC + MISC_BTE); float* bto = (float*)(ws + WS_MISC + MISC_BTO);
    bf16* memn = (bf16*)(ws + WS_MISC + MISC_MEMN); bf16* kvm = (bf16*)(ws + WS_MISC + MISC_KV);
    int* lists = (int*)(ws + WS_MISC + MISC_LIST); float* gatew = (float*)(ws + WS_MISC + MISC_GW); float* rsc = (float*)(ws + WS_MISC + MISC_RSC);
    float* ssqp = (float*)(ws + WS_MISC + MISC_SSQ);
    bf16* qx = (bf16*)(ws + WS_Z + Z_QX); bf16* ox = (bf16*)(ws + WS_Z + Z_OX); bf16* hid = (bf16*)(ws + WS_Z + Z_HID); bf16* ys = (bf16*)(ws + WS_Z + Z_YS); float* vn = (float*)(ws + WS_Z + Z_VN);
    unsigned* ctl = (unsigned*)(ws + WS_CTL);
    const int tid = otid(), lane = tid & 63, wv = tid >> 6; const int bid = obid();
    const int gtid = bid * NT + tid, GT = gridDim.x * NT;
    const int gw = bid * (NT / 64) + wv, NGW = gridDim.x * (NT / 64);
    const int il = layer >> 1;
    const bool even = (layer & 1) == 0;
    const int G = gridDim.x;

    if constexpr (PH == PH_INIT) {
        for (int i = gtid; i < 8 * 257; i += GT) { const int hh = i / 257, rel = i % 257 - 128; bte[i] = p.rel_table[t5_bucket(rel) * 8 + hh]; }
        for (int i = gtid; i < 3 * 8 * 129; i += GT) { const int g = i / (8 * 129), hh = (i / 129) % 8, j = i % 129 - 64; const int dil = g == 0 ? 1 : (g == 1 ? 4 : 16); bto[i] = p.rel_table[t5_bucket(j * dil) * 8 + hh]; }
        for (int r = gw; r < S; r += NGW) {
            const float4* s4 = (const float4*)(p.x + (size_t)r * D); float4 v[4]; float ss = 0.f;
#pragma unroll
            for (int j = 0; j < 4; ++j) { v[j] = s4[lane + 64 * j]; ss += v[j].x * v[j].x + v[j].y * v[j].y + v[j].z * v[j].z + v[j].w * v[j].w; }
            ss = wave_sum(ss);
            rms_row_bf16(v, 1.0f, nullptr, hb + (size_t)r * D, lane);
            if (lane < 16) ssqp[(size_t)r * 16 + lane] = lane == 0 ? ss : 0.f;
        }
        for (int r = gw; r < MEM; r += NGW) {
            const float4* s4 = (const float4*)(p.mem + (size_t)r * D); float4 v[4]; float ss = 0.f;
#pragma unroll
            for (int j = 0; j < 4; ++j) { v[j] = s4[lane + 64 * j]; ss += v[j].x * v[j].x + v[j].y * v[j].y + v[j].z * v[j].z + v[j].w * v[j].w; }
            const float rs = rsqrtf(wave_sum(ss) * (1.0f / D) + 1e-6f);
            for (int l = 0; l < DEPTH; ++l) rms_row_bf16(v, rs, p.ln_mem + l * D, memn + ((size_t)l * MEM + r) * D, lane);
        }
        CvtCtx c{gw, NGW, 0, lane, (LAS float*)(lds + wv * 16384)};
        auto idm = [](int n) { return n; };
        for (int i = 0; i < 2; ++i) {
            cvt_matrix(c, p.even_w_in + (size_t)i * D * EVEN_IN, D, EVEN_IN, p.ln_mix + (2 * i) * D, wnx + WO_W1E + i * W1E_SZ, idm);
            cvt_matrix(c, p.even_w_out + (size_t)i * D * D, D, D, nullptr, wnx + WO_W2E + i * W2_SZ, idm);
            cvt_matrix(c, p.odd_w_in + (size_t)i * D * ODD_IN, D, ODD_IN, p.ln_mix + (2 * i + 1) * D, wnx + WO_W1O + i * W1O_SZ, idm);
            cvt_matrix(c, p.odd_w_out + (size_t)i * D * D, D, D, nullptr, wnx + WO_W2O + i * W2_SZ, idm);
        }
        for (int l = 0; l < DEPTH; ++l) {
            cvt_matrix(c, p.xq_w + (size_t)l * D * 512, D, 512, p.ln_cross + l * D, wnx + WO_WQ + l * WQ_SZ, idm);
            cvt_matrix(c, p.xkv_w + (size_t)l * D * 1024, D, 1024, nullptr, wnx + WO_WKV + l * WKV_SZ, idm);
            cvt_matrix(c, p.xo_w + (size_t)l * 512 * D, 512, D, nullptr, wnx + WO_WO + l * WO_SZ, idm);
        }
    }
    if constexpr (PH == PH_EXPCVT) {
        CvtCtx c{gw, NGW, 0, lane, (LAS float*)(lds + wv * 16384)};
        const float* gf = p.ln_ffn + layer * D;
        for (int e = 0; e < 16; ++e) {
            cvt_matrix(c, p.ewg + ((size_t)layer * 16 + e) * D * 512, D, 512, gf, wex + e * WGU_SZ, [](int n) { return 8 * (n >> 2) + (n & 3); });
            cvt_matrix(c, p.ewu + ((size_t)layer * 16 + e) * D * 512, D, 512, gf, wex + e * WGU_SZ, [](int n) { return 8 * (n >> 2) + 4 + (n & 3); });
            cvt_matrix(c, p.ewd + ((size_t)layer * 16 + e) * 512 * D, 512, D, nullptr, wex + WEX_WD + e * WD_SZ, [](int n) { return n; });
        }
    }
    if constexpr (PH == PH_GEMM1) {
        const int N = even ? EVEN_IN : ODD_IN;
        const bf16* W = even ? wnx + WO_W1E + il * W1E_SZ : wnx + WO_W1O + il * W1O_SZ;
        pg8::DenseSched Sd; Sd.init(S, N, D, W, G, bid);
        pg8::EpiScaleBf16 E{z, N, ssqp, even ? 4 : 0};
        pg8::gemm_phase(lds, hb, D, Sd, E);
        if (layer == 0 && bid >= G - 16) {
            const int uidx = bid - (G - 16), l = uidx >> 2;
            pg8::DenseSched Sk; Sk.init(MEM, 1024, D, wnx + WO_WKV + l * WKV_SZ, 4, uidx & 3);
            pg8::EpiScaleBf16 Ek{kvm + (size_t)l * MEM * 1024, 1024, nullptr, 0};
            pg8::gemm_phase(lds, memn + (size_t)l * MEM * D, D, Sk, Ek);
        }
    }
    if constexpr (PH == PH_SGU1) {
        const float* lg = p.sgu_ln_g + il * 512; const float* lb = p.sgu_ln_b + il * 512;
        for (int t = gw; t < S; t += NGW) {
            float v[8]; float s = 0.f;
#pragma unroll
            for (int j = 0; j < 8; ++j) { v[j] = bf2f(z[(size_t)t * EVEN_IN + 512 + lane + 64 * j]); s += v[j]; }
            const float mu = wave_sum(s) * (1.f / 512.f); float q = 0.f;
#pragma unroll
            for (int j = 0; j < 8; ++j) { v[j] -= mu; q += v[j] * v[j]; }
            const float rstd = rsqrtf(wave_sum(q) * (1.f / 512.f) + 1e-6f);
#pragma unroll
            for (int j = 0; j < 8; ++j) { const int c = lane + 64 * j; vn[(size_t)t * 512 + c] = v[j] * rstd * lg[c] + lb[c]; }
        }
    }
    if constexpr (PH == PH_SGU2) {
        const float* wsg = p.sgu_w + (size_t)il * 4 * 128 * 128; const float* bs = p.sgu_b + il * 4 * 128;
        for (size_t i = gtid; i < (size_t)S * 512; i += GT) {
            const int t = (int)(i >> 9), ch = (int)(i & 511), g = ch >> 7, pp = t & 127, n0 = t & ~127;
            const float* wr = wsg + ((size_t)g * 128 + pp) * 128; float acc = 0.f;
            for (int q = 0; q < 128; ++q) acc += wr[q] * vn[(size_t)(n0 + q) * 512 + ch];
            acc += bs[g * 128 + pp];
            y[(size_t)t * D + ch] = f2bf(bf2f(z[(size_t)t * EVEN_IN + ch]) * acc);
        }
    }
    if constexpr (PH == PH_WATT) {
        const float* sink = p.attn_sink + il * 8;
        for (int it = gw; it < S * 8; it += NGW) {
            const int pos = it >> 3, hh = it & 7, kv = hh >> 2;
            const float q = bf2f(z[(size_t)pos * EVEN_IN + 1024 + hh * 64 + lane]);
            float m = sink[hh], den = 1.f, acc = 0.f;
            const int j0 = pos - 128 < 0 ? 0 : pos - 128, j1 = pos + 128 > S - 1 ? S - 1 : pos + 128;
            for (int j = j0; j <= j1; ++j) {
                const float kk = bf2f(z[(size_t)j * EVEN_IN + 1536 + kv * 64 + lane]);
                const float vv = bf2f(z[(size_t)j * EVEN_IN + 1664 + kv * 64 + lane]);
                const float sc = wave_sum(q * kk) * 0.125f + bte[hh * 257 + (j - pos + 128)];
                const float mn = fmaxf(m, sc), a = __expf(m - mn), pr = __expf(sc - mn);
                den = den * a + pr; acc = acc * a + pr * vv; m = mn;
            }
            y[(size_t)pos * D + 512 + hh * 64 + lane] = f2bf(acc / den);
        }
    }
    if constexpr (PH == PH_DATT) {
        for (int it = gw; it < S * 8; it += NGW) {
            const int pos = it >> 3, hh = it & 7;
            float m = -1e30f, den = 0.f, a0 = 0.f, a1 = 0.f;
            for (int g = 0; g < 3; ++g) {
                const int dil = g == 0 ? 1 : (g == 1 ? 4 : 16);
                const bf16* zq = z + (size_t)pos * ODD_IN + g * 3072 + hh * 128;
                const float q0 = bf2f(zq[lane]), q1 = bf2f(zq[lane + 64]);
                for (int j = -64; j <= 64; ++j) {
                    const int kp = pos + j * dil; if (kp < 0 || kp >= S) continue;
                    const bf16* zk = z + (size_t)kp * ODD_IN + g * 3072 + 1024 + hh * 128; const bf16* zv = zk + 1024;
                    const float sc = wave_sum(q0 * bf2f(zk[lane]) + q1 * bf2f(zk[lane + 64])) * 0.08838834764831845f + bto[(g * 8 + hh) * 129 + j + 64];
                    const float mn = fmaxf(m, sc), a = __expf(m - mn), pr = __expf(sc - mn);
                    den = den * a + pr; a0 = a0 * a + pr * bf2f(zv[lane]); a1 = a1 * a + pr * bf2f(zv[lane + 64]); m = mn;
                }
            }
            y[(size_t)pos * D + hh * 128 + lane] = f2bf(a0 / den); y[(size_t)pos * D + hh * 128 + lane + 64] = f2bf(a1 / den);
        }
    }
    if constexpr (PH == PH_GEMM2) {
        const bf16* W = even ? wnx + WO_W2E + il * W2_SZ : wnx + WO_W2O + il * W2_SZ;
        pg8::DenseSched Sd; Sd.init(S, D, D, W, G, bid);
        pg8::EpiResidual E{layer == 0 ? p.x : h, h, hb, ssqp};
        pg8::gemm_phase(lds, y, D, Sd, E);
    }
    if constexpr (PH == PH_GEMM3) {
        pg8::DenseSched Sd; Sd.init(S, 512, D, wnx + WO_WQ + layer * WQ_SZ, G, bid);
        pg8::EpiScaleBf16 E{qx, 512, ssqp, 0};
        pg8::gemm_phase(lds, hb, D, Sd, E);
    }
    if constexpr (PH == PH_XATT) {
        const bf16* kvl = kvm + (size_t)layer * MEM * 1024;
        for (int it = gw; it < S * 4; it += NGW) {
            const int pos = it >> 2, hh = it & 3;
            const float q0 = bf2f(qx[(size_t)pos * 512 + hh * 128 + lane]), q1 = bf2f(qx[(size_t)pos * 512 + hh * 128 + lane + 64]);
            float m = -1e30f, den = 0.f, a0 = 0.f, a1 = 0.f;
            for (int j = 0; j < MEM; ++j) {
                const bf16* kr = kvl + (size_t)j * 1024 + hh * 128; const bf16* vr = kr + 512;
                const float sc = wave_sum(q0 * bf2f(kr[lane]) + q1 * bf2f(kr[lane + 64])) * 0.08838834764831845f;
                const float mn = fmaxf(m, sc), a = __expf(m - mn), pr = __expf(sc - mn);
                den = den * a + pr; a0 = a0 * a + pr * bf2f(vr[lane]); a1 = a1 * a + pr * bf2f(vr[lane + 64]); m = mn;
            }
            ox[(size_t)pos * 512 + hh * 128 + lane] = f2bf(a0 / den); ox[(size_t)pos * 512 + hh * 128 + lane + 64] = f2bf(a1 / den);
        }
    }
    if constexpr (PH == PH_GEMM4) {
        pg8::DenseSched Sd; Sd.init(S, D, 512, wnx + WO_WO + layer * WO_SZ, G, bid);
        pg8::EpiResidual E{h, h, hb, ssqp};
        pg8::gemm_phase(lds, ox, 512, Sd, E);
    }
    if constexpr (PH == PH_ROUTE) {
        const float* wg = p.rgw + (size_t)layer * D * 4; const float* we = p.rew + (size_t)layer * D * 16;
        const float* bg = p.rgb + layer * 4; const float* be = p.reb + layer * 16; const float* gf = p.ln_ffn + layer * D;
        for (int t = gw; t < S; t += NGW) {
            float ssq = lane < 16 ? ssqp[(size_t)t * 16 + lane] : 0.f; ssq = wave_sum(ssq);
            const float rs = rsqrtf(ssq * (1.0f / D) + 1e-6f);
            float lg[4], le[16];
#pragma unroll
            for (int c = 0; c < 4; ++c) lg[c] = 0.f;
#pragma unroll
            for (int c = 0; c < 16; ++c) le[c] = 0.f;
            for (int k = lane; k < D; k += 64) {
                const float xv = h[(size_t)t * D + k] * rs * gf[k];
                const float4 g4 = *(const float4*)(wg + (size_t)k * 4);
                lg[0] += xv * g4.x; lg[1] += xv * g4.y; lg[2] += xv * g4.z; lg[3] += xv * g4.w;
#pragma unroll
                for (int c4 = 0; c4 < 4; ++c4) { const float4 e4 = *(const float4*)(we + (size_t)k * 16 + c4 * 4); le[c4 * 4 + 0] += xv * e4.x; le[c4 * 4 + 1] += xv * e4.y; le[c4 * 4 + 2] += xv * e4.z; le[c4 * 4 + 3] += xv * e4.w; }
            }
#pragma unroll
            for (int c = 0; c < 4; ++c) lg[c] = wave_sum(lg[c]) + bg[c];
#pragma unroll
            for (int c = 0; c < 16; ++c) le[c] = wave_sum(le[c]) + be[c];
            if (lane == 0) {
                int grp = 0; float gm = lg[0];
#pragma unroll
                for (int c = 1; c < 4; ++c) if (lg[c] > gm) { gm = lg[c]; grp = c; }
                float gs = 0.f;
#pragma unroll
                for (int c = 0; c < 4; ++c) gs += __expf(lg[c] - gm);
                const float ggate = 1.0f / gs;
                float es[4];
#pragma unroll
                for (int e = 0; e < 4; ++e) es[e] = grp == 0 ? le[e] : (grp == 1 ? le[4 + e] : (grp == 2 ? le[8 + e] : le[12 + e]));
                int i0 = 0; float v0 = es[0];
#pragma unroll
                for (int e = 1; e < 4; ++e) if (es[e] > v0) { v0 = es[e]; i0 = e; }
                int i1 = -1; float v1 = -3.0e38f;
#pragma unroll
                for (int e = 0; e < 4; ++e) if (e != i0 && es[e] > v1) { v1 = es[e]; i1 = e; }
                const float ex = __expf(v1 - v0); const float w0 = 1.0f / (1.0f + ex), w1 = ex / (1.0f + ex);
                const int E0 = grp * 4 + i0, E1 = grp * 4 + i1;
                const unsigned p0 = atomicAdd(&ctl[CW_CNT + (layer * 16 + E0) * 64], 1u);
                const unsigned p1 = atomicAdd(&ctl[CW_CNT + (layer * 16 + E1) * 64], 1u);
                lists[E0 * LCAP + p0] = 2 * t; lists[E1 * LCAP + p1] = 2 * t + 1;
                gatew[2 * t] = ggate * w0; gatew[2 * t + 1] = ggate * w1;
                rsc[2 * t] = rs; rsc[2 * t + 1] = rs;
            }
        }
    }
    if constexpr (PH == PH_MOE1 || PH == PH_MOE2) {
        LAS int* moe = (LAS int*)(lds + LDS_MOE);
        if (tid == 0) { int acc = 0; for (int e = 0; e < 16; ++e) { const int c = (int)ctl[CW_CNT + (layer * 16 + e) * 64]; moe[e] = acc; moe[17 + e] = c; acc += (c + 255) >> 8; } moe[16] = acc; }
        __syncthreads();
        if constexpr (PH == PH_MOE1) {
            pg8::MoeSched<true> Sm{4, G, bid, D, wex, WGU_SZ, lists, moe};
            pg8::EpiMoe1 E{hid, lists, rsc, gatew};
            pg8::gemm_phase(lds, hb, D, Sm, E);
        } else {
            pg8::MoeSched<false> Sm{4, G, bid, 512, wex + WEX_WD, WD_SZ, lists, moe};
            pg8::EpiMoe2 E{ys, lists};
            pg8::gemm_phase(lds, hid, 512, Sm, E);
        }
        __syncthreads();
    }
    if constexpr (PH == PH_FIN) {
        for (int r = gw; r < S; r += NGW) {
            const float4* s4 = (const float4*)(h + (size_t)r * D); float4 v[4]; float ss = 0.f;
            const u32x2* y0 = (const u32x2*)(ys + (size_t)(2 * r) * D); const u32x2* y1 = (const u32x2*)(ys + (size_t)(2 * r + 1) * D);
#pragma unroll
            for (int j = 0; j < 4; ++j) {
                v[j] = s4[lane + 64 * j]; const u32x2 a = y0[lane + 64 * j], b = y1[lane + 64 * j];
                v[j].x += __uint_as_float(a.x << 16) + __uint_as_float(b.x << 16); v[j].y += __uint_as_float(a.x & 0xffff0000u) + __uint_as_float(b.x & 0xffff0000u);
                v[j].z += __uint_as_float(a.y << 16) + __uint_as_float(b.y << 16); v[j].w += __uint_as_float(a.y & 0xffff0000u) + __uint_as_float(b.y & 0xffff0000u);
                ss += v[j].x * v[j].x + v[j].y * v[j].y + v[j].z * v[j].z + v[j].w * v[j].w;
            }
            ss = wave_sum(ss);
            if (layer == DEPTH - 1) {
                const float rs = rsqrtf(ss * (1.0f / D) + 1e-6f); float4* o4 = (float4*)(p.out + (size_t)r * D);
#pragma unroll
                for (int j = 0; j < 4; ++j) { const float4 gg = ((const float4*)p.ln_final)[lane + 64 * j]; float4 o; o.x = v[j].x * rs * gg.x; o.y = v[j].y * rs * gg.y; o.z = v[j].z * rs * gg.z; o.w = v[j].w * rs * gg.w; o4[lane + 64 * j] = o; }
            } else {
                float4* d4 = (float4*)(h + (size_t)r * D);
#pragma unroll
                for (int j = 0; j < 4; ++j) d4[lane + 64 * j] = v[j];
                rms_row_bf16(v, 1.0f, nullptr, hb + (size_t)r * D, lane);
                if (lane < 16) ssqp[(size_t)r * 16 + lane] = lane == 0 ? ss : 0.f;
            }
        }
    }
}

__global__ void __launch_bounds__(NT, 2) k_mega(Params p) {
    extern __shared__ __attribute__((aligned(16))) unsigned char lds_[];
    LAS unsigned char* lds = (LAS unsigned char*)lds_;
    if (threadIdx.x < 4) ((LAS unsigned*)(lds + LDS_BARW))[threadIdx.x] = 0u;
    __syncthreads();
    XcdBarrier bar = xcd_barrier_post((unsigned*)(p.ws + WS_CTL) + CW_BAR, (volatile LAS unsigned*)(lds + LDS_BARW));
#define PHB(PH, l) do { run_phase<PH>(p, l, lds); xcd_barrier(bar); } while (0)
    PHB(PH_INIT, 0);
    for (int l = 0; l < DEPTH; ++l) {
        PHB(PH_GEMM1, l);
        if ((l & 1) == 0) { PHB(PH_SGU1, l); run_phase<PH_SGU2>(p, l, lds); PHB(PH_WATT, l); } else { PHB(PH_DATT, l); }
        PHB(PH_GEMM2, l); PHB(PH_GEMM3, l); PHB(PH_XATT, l); run_phase<PH_EXPCVT>(p, l, lds); __syncthreads(); PHB(PH_GEMM4, l);
        PHB(PH_ROUTE, l); PHB(PH_MOE1, l); PHB(PH_MOE2, l);
        if (l == DEPTH - 1) run_phase<PH_FIN>(p, l, lds); else PHB(PH_FIN, l);
    }
#undef PHB
}

extern "C" void kernel_launch(void* const* d_in, const int* in_sizes, int n_in, void* d_out, int out_size, void* d_ws, size_t ws_size, hipStream_t stream) {
    if (n_in != 27 || ws_size < WS_END) { fprintf(stderr, "kernel_launch: unexpected n_in %d or ws_size %zu\n", n_in, ws_size); return; }
    Params p{};
    const float** pp = (const float**)&p;
    for (int i = 0; i < 27; ++i) pp[i] = (const float*)d_in[i];
    p.out = (float*)d_out; p.ws = (unsigned char*)d_ws;
    (void)hipMemsetAsync((char*)d_ws + WS_CTL, 0, 1 * MiB, stream);
    static int grid = 0;
    if (grid == 0) {
        int dev = 0, cus = 0, per_cu = 0;
        if (hipGetDevice(&dev) != hipSuccess || hipDeviceGetAttribute(&cus, hipDeviceAttributeMultiprocessorCount, dev) != hipSuccess) { grid = -1; return; }
        if (hipFuncSetAttribute((const void*)k_mega, hipFuncAttributeMaxDynamicSharedMemorySize, LDS_BYTES) != hipSuccess) { fprintf(stderr, "hipFuncSetAttribute failed\n"); grid = -1; return; }
        if (hipOccupancyMaxActiveBlocksPerMultiprocessor(&per_cu, (const void*)k_mega, NT, LDS_BYTES) != hipSuccess || per_cu < 1) { fprintf(stderr, "occupancy query: %d\n", per_cu); grid = -1; return; }
        (void)hipGetLastError();
        grid = cus;
    }
    if (grid < 0) return;
    hipLaunchKernelGGL(k_mega, dim3(grid), dim3(NT), LDS_BYTES, stream, p);
}
```

```cpp
#include <hip/hip_runtime.h>
#include <cstdio>
#include <cstdint>

typedef unsigned short bf16;
#define LAS __attribute__((address_space(3)))
typedef short bf16x8 __attribute__((ext_vector_type(8)));
typedef float f32x4 __attribute__((ext_vector_type(4)));
typedef float f32x16 __attribute__((ext_vector_type(16)));
typedef unsigned u32x4 __attribute__((ext_vector_type(4)));
typedef unsigned u32x2 __attribute__((ext_vector_type(2)));

constexpr int S = 16384, D = 1024, DEPTH = 4, MEM = 256;
constexpr int EVEN_IN = 1792, ODD_IN = 9216;
constexpr int NT = 512;
constexpr int LCAP = 16384;
constexpr size_t MiB = 1u << 20;
constexpr size_t WS_CTL = 0;
constexpr size_t WS_H = 1 * MiB;
constexpr size_t WS_HB = 65 * MiB;
constexpr size_t WS_Y = 97 * MiB;
constexpr size_t WS_Z = 129 * MiB;
constexpr size_t WS_WNX = 417 * MiB;
constexpr size_t WS_WEX = 484 * MiB;
constexpr size_t WS_MISC = 532 * MiB;
constexpr size_t WS_END = 548 * MiB;
constexpr size_t MISC_BTE = 0;
constexpr size_t MISC_BTO = 16384;
constexpr size_t MISC_SGW = 65536;
constexpr size_t MISC_MEMN = 1 * MiB;
constexpr size_t MISC_KV = 3 * MiB;
constexpr size_t MISC_LIST = 5 * MiB;
constexpr size_t MISC_GW = 6 * MiB;
constexpr size_t MISC_RSC = 6 * MiB + 131072;
constexpr size_t MISC_SSQ = 7 * MiB;
constexpr size_t MISC_LSE = 8 * MiB;
constexpr size_t Z_QX = 0;
constexpr size_t Z_OX = 16 * MiB;
constexpr size_t Z_HID = 32 * MiB;
constexpr size_t Z_VN = 64 * MiB;
constexpr size_t Z_YS = 96 * MiB;
constexpr size_t W1E_SZ = (size_t)EVEN_IN * D, W2_SZ = (size_t)D * D, W1O_SZ = (size_t)ODD_IN * D, WQ_SZ = (size_t)512 * D, WKV_SZ = (size_t)1024 * D, WO_SZ = (size_t)D * 512;
constexpr size_t WO_W1E = 0, WO_W2E = WO_W1E + 2 * W1E_SZ, WO_W1O = WO_W2E + 2 * W2_SZ, WO_W2O = WO_W1O + 2 * W1O_SZ, WO_WQ = WO_W2O + 2 * W2_SZ, WO_WKV = WO_WQ + 4 * WQ_SZ, WO_WO = WO_WKV + 4 * WKV_SZ, WO_END = WO_WO + 4 * WO_SZ;
static_assert(WO_END * 2 <= 67 * MiB, "non-expert weights fit");
constexpr size_t WGU_SZ = (size_t)1024 * 1024, WD_SZ = (size_t)1024 * 512;
constexpr size_t WEX_WD = 16 * WGU_SZ;
constexpr int CW_CNT = 1024;
constexpr int CW_BAR = 8192;
constexpr int LDS_BYTES = 147456;
constexpr int LDS_BARW = 131072;
constexpr int LDS_MOE = 131072 + 64;

struct Params {
    const float *x, *mem, *ln_mix, *ln_cross, *ln_mem, *ln_ffn, *ln_final, *rel_table,
        *even_w_in, *even_w_out, *sgu_ln_g, *sgu_ln_b, *sgu_w, *sgu_b, *attn_sink,
        *odd_w_in, *odd_w_out, *xq_w, *xkv_w, *xo_w, *rgw, *rgb, *rew, *reb, *ewg, *ewu, *ewd;
    float* out;
    unsigned char* ws;
};

__device__ __forceinline__ int otid() { int t = threadIdx.x; asm volatile("" : "+v"(t)); return t; }
__device__ __forceinline__ int obid() { int t = blockIdx.x; asm volatile("" : "+s"(t)); return t; }
__device__ __forceinline__ float bf2f(bf16 b) { return __uint_as_float(((unsigned)b) << 16); }
__device__ __forceinline__ bf16 f2bf(float f) { unsigned u = __float_as_uint(f); u += 0x7fffu + ((u >> 16) & 1u); return (bf16)(u >> 16); }
__device__ __forceinline__ unsigned cvt_pk_bf16(float lo, float hi) { unsigned r; asm volatile("v_cvt_pk_bf16_f32 %0, %1, %2" : "=v"(r) : "v"(lo), "v"(hi)); return r; }
__device__ __forceinline__ float wave_sum(float v) {
#pragma unroll
    for (int o = 1; o < 64; o <<= 1) v += __shfl_xor(v, o);
    return v;
}
__device__ __forceinline__ float gelu_tanh(float x) {
    const float u2 = 1.5957691216057308f * (x + 0.044715f * x * x * x);
    return x * __builtin_amdgcn_rcpf(1.0f + __expf(-u2));
}
__device__ __forceinline__ int t5_bucket(int rel) {
    const int ret = rel > 0 ? 16 : 0;
    const int n = rel < 0 ? -rel : rel;
    if (n < 8) return ret + n;
    const float nf = (float)n;
    int large = 8 + (int)(logf(nf / 8.0f) / 4.852030263919617f * 8.0f);
    large = large < 15 ? large : 15;
    return ret + large;
}

#define XB_TMO      128
#define XB_XCNT(j)  (256  + 64 * (j))
#define XB_XSUB(j)  (1280 + 64 * (j))
#define XB_XGEN(j)  (2304 + 64 * (j))
#define XB_TOP      3328
#define XB_TOPGEN   3392
#define XCD_BAR_WORDS 3456
#define XB_SPIN_CAP (1u << 22)
__device__ __forceinline__ unsigned xb_ld(unsigned* p)              { return __hip_atomic_load(p, __ATOMIC_RELAXED, __HIP_MEMORY_SCOPE_AGENT); }
__device__ __forceinline__ unsigned xb_add(unsigned* p, unsigned v) { return __hip_atomic_fetch_add(p, v, __ATOMIC_RELAXED, __HIP_MEMORY_SCOPE_AGENT); }
__device__ __forceinline__ unsigned xb_xcc_id() { return (unsigned)__builtin_amdgcn_s_getreg((3 << 11) | 20) & 0xFu; }
#define XB_SPIN(cond, bar) do { unsigned _sp = 0; while (cond) { __builtin_amdgcn_s_sleep(1); \
    if ((++_sp & 255u) == 0u) { if (xb_ld(&(bar)[XB_TMO])) break; if (_sp > XB_SPIN_CAP) { atomicAdd(&(bar)[XB_TMO], 1u); break; } } } } while (0)
struct XcdBarrier { unsigned* bar; unsigned x; volatile LAS unsigned* st; };
__device__ __forceinline__ XcdBarrier xcd_barrier_post(unsigned* bar, volatile LAS unsigned* st) {
    XcdBarrier b; b.bar = bar; b.x = (unsigned)__builtin_amdgcn_readfirstlane((int)xb_xcc_id()); b.st = st;
    if (threadIdx.x == 0) (void)xb_add(&bar[XB_XCNT(b.x)], 1u);
    return b;
}
__device__ __forceinline__ void xcd_barrier_complete(unsigned* bar, unsigned x, unsigned& nloc, unsigned& nx) {
    const unsigned G = gridDim.x * gridDim.y * gridDim.z;
    unsigned sum, cnt, mine, sp = 0u;
    for (;;) {
        sum = 0u; cnt = 0u; mine = 0u;
#pragma unroll
        for (unsigned j = 0; j < 16; ++j) { const unsigned c = xb_ld(&bar[XB_XCNT(j)]); sum += c; cnt += (c > 0u) ? 1u : 0u; mine = (j == x) ? c : mine; }
        if (sum == G) break;
        __builtin_amdgcn_s_sleep(1);
        if ((++sp & 255u) == 0u) { if (xb_ld(&bar[XB_TMO])) break; if (sp > XB_SPIN_CAP) { atomicAdd(&bar[XB_TMO], 1u); break; } }
    }
    nloc = mine > 0u ? mine : 1u; nx = cnt > 0u ? cnt : 1u;
}
__device__ __forceinline__ void xcd_barrier(const XcdBarrier& b) {
    asm volatile("s_waitcnt vmcnt(0)" ::: "memory");
    __syncthreads();
    if (threadIdx.x == 0) {
        unsigned* bar = b.bar; unsigned bx = b.x; asm volatile("" : "+s"(bar), "+s"(bx));
        __builtin_amdgcn_s_waitcnt(0);
        unsigned nloc = b.st[0], nx = b.st[1];
        if (nloc == 0u) { xcd_barrier_complete(bar, bx, nloc, nx); b.st[0] = nloc; b.st[1] = nx; }
        const unsigned old = xb_add(&bar[XB_XSUB(bx)], 1u);
        const unsigned gen = old / nloc;
        if (old + 1u == (gen + 1u) * nloc) {
            __builtin_amdgcn_fence(__ATOMIC_RELEASE, "agent");
            asm volatile("s_waitcnt vmcnt(0)" ::: "memory");
            const unsigned og = xb_add(&bar[XB_TOP], 1u);
            const unsigned tg = og / nx;
            if (og + 1u == (tg + 1u) * nx) xb_add(&bar[XB_TOPGEN], 1u);
            else XB_SPIN(xb_ld(&bar[XB_TOPGEN]) == tg, bar);
            __builtin_amdgcn_fence(__ATOMIC_ACQUIRE, "agent");
            xb_add(&bar[XB_XGEN(bx)], 1u);
            asm volatile("s_waitcnt vmcnt(0)" ::: "memory");
        } else {
            XB_SPIN(xb_ld(&bar[XB_XGEN(bx)]) == gen, bar);
            __builtin_amdgcn_fence(__ATOMIC_ACQUIRE, "agent");
            asm volatile("s_waitcnt vmcnt(0)" ::: "memory");
        }
    }
    __syncthreads();
}

namespace pg8 {
constexpr int BM = 256, BK = 64, HALF = 128, HTB = HALF * BK * 2, STAGE_BYTES = 8 * HTB, NXCD = 8, WGM = 8;
__host__ __device__ __forceinline__ int lds_byte(int r, int c) { const int st = (r >> 4) * 2 + (c >> 5), rr = r & 15, cc = c & 31, ob = rr * 64 + cc * 2; return st * 1024 + (ob ^ (((ob >> 9) & 1) << 5)); }
__host__ __device__ __forceinline__ void stage_rc(int b, int& R, int& C) { const int st = b / 1024, sb = b % 1024, swz = sb ^ (((sb >> 9) & 1) << 5); R = (st >> 1) * 16 + swz / 64; C = (st & 1) * 32 + (swz % 64) / 2; }
__host__ __device__ __forceinline__ int perm32(int rho) { const int n = rho >> 4, i = rho & 15; return 8 * (i >> 2) + 4 * n + (i & 3); }
struct Unit { int pm, pn, e, rows; };

struct DenseSched {
    int nM, nN, nwg, G, c, K; const bf16* Bt;
    __device__ void init(int M, int N, int K_, const bf16* Bt_, int G_, int c_) { nM = M / BM; nN = N / BM; nwg = nM * nN; G = G_; c = c_; K = K_; Bt = Bt_; }
    __device__ __forceinline__ bool next(int i, Unit& u) const {
        const long L = (long)i * G + c; if (L >= nwg) return false;
        int wgid = (int)L; { const int q = nwg / NXCD, r = nwg % NXCD, xcd = wgid % NXCD, off = wgid / NXCD; wgid = (xcd < r ? xcd * (q + 1) : r * (q + 1) + (xcd - r) * q) + off; }
        const int nig = WGM * nN, gid = wgid / nig, fm = gid * WGM, gsz = (nM - fm) < WGM ? (nM - fm) : WGM;
        u.pm = fm + ((wgid % nig) % gsz); u.pn = (wgid % nig) / gsz; u.e = 0; u.rows = 256; return true;
    }
    __device__ __forceinline__ unsigned arow(const Unit& u, int r) const { return (unsigned)(u.pm * BM + r) * (unsigned)(K * 2); }
    __device__ __forceinline__ const char* bbase(const Unit& u) const { return (const char*)Bt + (size_t)u.pn * BM * K * 2; }
};
template <bool TOKEN_ROWS>
struct MoeSched {
    int nN, G, c, K; const bf16* Bt; size_t bstride; const int* list; const LAS int* moe;
    __device__ __forceinline__ bool next(int i, Unit& u) const {
        const int L = i * G + c; const int total = moe[16] * nN; if (L >= total) return false;
        const int rt = L / nN; u.pn = L % nN; int e = 0;
#pragma unroll
        for (int j = 1; j < 16; ++j) e = (rt >= moe[j]) ? j : e;
        u.e = e; u.pm = rt - moe[e]; const int left = moe[17 + e] - u.pm * BM; u.rows = left < BM ? left : BM; return true;
    }
    __device__ __forceinline__ unsigned arow(const Unit& u, int r) const {
        const int idx = r < u.rows ? r : u.rows - 1; const int slot = list[u.e * LCAP + u.pm * BM + idx];
        return (unsigned)(TOKEN_ROWS ? (slot >> 1) : slot) * (unsigned)(K * 2);
    }
    __device__ __forceinline__ const char* bbase(const Unit& u) const { return (const char*)Bt + ((size_t)u.e * bstride + (size_t)u.pn * BM * K) * 2; }
};

template <class Epi, class Sched>
__device__ __forceinline__ void gemm_phase(LAS unsigned char* lds, const bf16* Abase, const int K, const Sched& S, const Epi& E) {
    const int tid = otid(), wid = __builtin_amdgcn_readfirstlane(tid >> 6), lane = tid & 63, wr = wid >> 2, wc = wid & 3, fr = lane & 15, fq = lane >> 4;
    const int nt = K / BK;
    unsigned voffB[2];
#pragma unroll
    for (int i = 0; i < 2; ++i) { int R, C; stage_rc(tid * 16 + i * 8192, R, C); const int Rb = Epi::PERM ? ((R & ~31) + perm32(R & 31)) : R;
        voffB[i] = (unsigned)(Rb * K + C) * 2u; }
#define PG8_AOFFS(u, o0, o1) do { const int _t = otid(); _Pragma("unroll") for (int _i = 0; _i < 2; ++_i) { int _R, _C; stage_rc(_t * 16 + _i * 8192, _R, _C); \
        o0[_i] = S.arow(u, _R) + (unsigned)_C * 2u; o1[_i] = S.arow(u, HALF + _R) + (unsigned)_C * 2u; } } while (0)
    const size_t kstep = (size_t)(BK * 2);
    const size_t hstep = (size_t)HALF * K * 2;
    const unsigned ldsw = (unsigned)wid * 1024u;
    const int aoff = lds_byte(wr * 64 + fr, fq * 8), boff = lds_byte(wc * 32 + fr, fq * 8);
    const char* Ab = (const char*)Abase;
#define PG8_SA(b, h) (((b) * 2 + (h)) * HTB)
#define PG8_SB(b, h) ((4 + (b) * 2 + (h)) * HTB)
#define PG8_STAGE(bufoff, gbase, voff) do { _Pragma("unroll") for (int _i = 0; _i < 2; ++_i) \
        __builtin_amdgcn_global_load_lds((const unsigned*)((const char*)(gbase) + (voff)[_i]), (LAS unsigned*)(lds + (bufoff) + ldsw + _i * 8192), 16, 0, 0); } while (0)
#define PG8_LDA(dst, b, h) do { _Pragma("unroll") for (int m = 0; m < 4; ++m) _Pragma("unroll") for (int k = 0; k < 2; ++k) dst[m][k] = *(const LAS bf16x8*)(lds + PG8_SA(b, h) + aoff + m * 2048 + k * 1024); } while (0)
#define PG8_LDB(dst, b, h) do { _Pragma("unroll") for (int n = 0; n < 2; ++n) _Pragma("unroll") for (int k = 0; k < 2; ++k) dst[n][k] = *(const LAS bf16x8*)(lds + PG8_SB(b, h) + boff + n * 2048 + k * 1024); } while (0)
#define PG8_MMA(ai, bj, At, Bt) do { __builtin_amdgcn_s_setprio(1); _Pragma("unroll") for (int m = 0; m < 4; ++m) _Pragma("unroll") for (int n = 0; n < 2; ++n) _Pragma("unroll") for (int k = 0; k < 2; ++k) \
        acc[ai][bj][m][n] = __builtin_amdgcn_mfma_f32_16x16x32_bf16(Bt[n][k], At[m][k], acc[ai][bj][m][n], 0, 0, 0); __builtin_amdgcn_s_setprio(0); } while (0)
#define PG8_WAIT_V(n) asm volatile("s_waitcnt vmcnt(" #n ")" ::: "memory")
#define PG8_WAIT_L(n) asm volatile("s_waitcnt lgkmcnt(" #n ")" ::: "memory")
#define PG8_BAR __builtin_amdgcn_s_barrier()
#define PG8_SCHED __builtin_amdgcn_sched_barrier(0)
    Unit cur, nxt; int ui = 0;
    if (!S.next(0, cur)) return;
    f32x4 acc[2][2][4][2];
#pragma unroll
    for (int a = 0; a < 2; ++a)
#pragma unroll
        for (int b = 0; b < 2; ++b)
#pragma unroll
            for (int m = 0; m < 4; ++m)
#pragma unroll
                for (int n = 0; n < 2; ++n) acc[a][b][m][n] = (f32x4){0.f, 0.f, 0.f, 0.f};
    bf16x8 At[4][2], B0[2][2], B1[2][2];
    unsigned oA0[2], oA1[2], oN0[2], oN1[2];
    PG8_AOFFS(cur, oA0, oA1);
    const char* cB = S.bbase(cur);
    PG8_STAGE(PG8_SB(0, 0), cB, voffB); PG8_STAGE(PG8_SB(0, 1), cB + hstep, voffB); PG8_STAGE(PG8_SA(0, 0), Ab, oA0); PG8_STAGE(PG8_SA(0, 1), Ab, oA1);
    if (wr == 1) PG8_BAR;
    PG8_WAIT_V(2); PG8_BAR;
    PG8_STAGE(PG8_SB(1, 0), cB + kstep, voffB); PG8_STAGE(PG8_SA(1, 0), Ab + kstep, oA0); PG8_STAGE(PG8_SB(1, 1), cB + hstep + kstep, voffB);
    PG8_WAIT_V(6); PG8_BAR;
    for (;;) {
        const bool has_next = S.next(ui + 1, nxt);
        const char* nB = has_next ? S.bbase(nxt) : cB;
        if (has_next) {
            PG8_AOFFS(nxt, oN0, oN1);
        } else {
#pragma unroll
            for (int i = 0; i < 2; ++i) { oN0[i] = oA0[i]; oN1[i] = oA1[i]; }
        }
        for (int t = 0; t < nt; t += 2) {
            const bool last = (t == nt - 2);
            const char* a1 = Ab + (size_t)(t + 1) * kstep;
            const char* a2 = last ? Ab : Ab + (size_t)(t + 2) * kstep; const char* b2 = last ? nB : cB + (size_t)(t + 2) * kstep;
            const char* a3 = a2 + kstep; const char* b3 = b2 + kstep;
            unsigned p0[2], p1[2];
#pragma unroll
            for (int i = 0; i < 2; ++i) { p0[i] = last ? oN0[i] : oA0[i]; p1[i] = last ? oN1[i] : oA1[i]; }
            PG8_LDB(B0, 0, 0); PG8_LDB(B1, 0, 1); PG8_SCHED; PG8_LDA(At, 0, 0); PG8_STAGE(PG8_SA(1, 1), a1, oA1);
            PG8_WAIT_V(8); PG8_WAIT_L(0); PG8_BAR; PG8_MMA(0, 0, At, B0); PG8_MMA(0, 1, At, B1); PG8_BAR; PG8_SCHED;
            PG8_LDA(At, 0, 1); PG8_STAGE(PG8_SB(0, 0), b2, voffB); PG8_STAGE(PG8_SB(0, 1), b2 + hstep, voffB); PG8_STAGE(PG8_SA(0, 0), a2, p0);
            PG8_WAIT_V(8); PG8_WAIT_L(0); PG8_BAR; PG8_MMA(1, 0, At, B0); PG8_MMA(1, 1, At, B1); PG8_BAR; PG8_SCHED;
            PG8_LDB(B0, 1, 0); PG8_LDB(B1, 1, 1); PG8_SCHED; PG8_LDA(At, 1, 0); PG8_STAGE(PG8_SA(0, 1), a2, p1);
            PG8_WAIT_V(8); PG8_WAIT_L(0); PG8_BAR; PG8_MMA(0, 0, At, B0); PG8_MMA(0, 1, At, B1); PG8_BAR; PG8_SCHED;
            PG8_LDA(At, 1, 1); PG8_STAGE(PG8_SB(1, 0), b3, voffB); PG8_STAGE(PG8_SB(1, 1), b3 + hstep, voffB); PG8_STAGE(PG8_SA(1, 0), a3, p0);
            PG8_WAIT_V(8); PG8_WAIT_L(0); PG8_BAR; PG8_MMA(1, 0, At, B0); PG8_MMA(1, 1, At, B1); PG8_BAR; PG8_SCHED;
        }
        if (wr == 0) PG8_BAR;
        E(acc, cur, wr, wc, fr, fq);
        if (!has_next) break;
#pragma unroll
        for (int a = 0; a < 2; ++a)
#pragma unroll
            for (int b = 0; b < 2; ++b)
#pragma unroll
                for (int m = 0; m < 4; ++m)
#pragma unroll
                    for (int n = 0; n < 2; ++n) acc[a][b][m][n] = (f32x4){0.f, 0.f, 0.f, 0.f};
        cur = nxt; cB = nB; ++ui;
#pragma unroll
        for (int i = 0; i < 2; ++i) { oA0[i] = oN0[i]; oA1[i] = oN1[i]; }
        if (wr == 1) PG8_BAR;
    }
    PG8_WAIT_V(0);
    PG8_BAR;
#undef PG8_AOFFS
#undef PG8_SA
#undef PG8_SB
#undef PG8_STAGE
#undef PG8_LDA
#undef PG8_LDB
#undef PG8_MMA
#undef PG8_WAIT_V
#undef PG8_WAIT_L
#undef PG8_BAR
#undef PG8_SCHED
}

__device__ __forceinline__ float row_rs(const float* ssqp, int row, int fq) {
    const f32x4 pp = *(const f32x4*)(ssqp + (size_t)row * 16 + 4 * fq);
    float s = (pp[0] + pp[1]) + (pp[2] + pp[3]);
    s += __shfl_xor(s, 16); s += __shfl_xor(s, 32);
    return rsqrtf(s * (1.0f / 1024.0f) + 1e-6f);
}
struct EpiScaleBf16 {
    static constexpr bool PERM = true;
    bf16* O; int ldc; const float* ssqp; int gelu_tiles;
    __device__ __forceinline__ void operator()(const f32x4 (&acc)[2][2][4][2], const Unit& u, int wr, int wc, int fr, int fq) const {
        const int row0 = u.pm * BM + wr * 64 + fr, col0 = u.pn * BM + wc * 32 + 8 * fq;
        const bool gl = u.pn < gelu_tiles;
#pragma unroll
        for (int ai = 0; ai < 2; ++ai)
#pragma unroll
            for (int m = 0; m < 4; ++m) {
                const int row = row0 + ai * HALF + m * 16;
                const float rs = ssqp ? row_rs(ssqp, row, fq) : 1.0f;
                bf16* rowp = O + (size_t)row * ldc + col0;
#pragma unroll
                for (int bj = 0; bj < 2; ++bj) {
                    f32x4 v0 = acc[ai][bj][m][0] * rs, v1 = acc[ai][bj][m][1] * rs;
                    if (gl) {
#pragma unroll
                        for (int j = 0; j < 4; ++j) { v0[j] = gelu_tanh(v0[j]); v1[j] = gelu_tanh(v1[j]); }
                    }
                    u32x4 w; w.x = cvt_pk_bf16(v0[0], v0[1]); w.y = cvt_pk_bf16(v0[2], v0[3]); w.z = cvt_pk_bf16(v1[0], v1[1]); w.w = cvt_pk_bf16(v1[2], v1[3]);
                    *(u32x4*)(rowp + bj * HALF) = w;
                }
            }
    }
};
struct EpiResidual {
    static constexpr bool PERM = false;
    const float* base; float* h; bf16* hb; float* ssqp;
    __device__ __forceinline__ void operator()(const f32x4 (&acc)[2][2][4][2], const Unit& u, int wr, int wc, int fr, int fq) const {
        const int row0 = u.pm * BM + wr * 64 + fr, col0 = u.pn * BM + wc * 32 + 4 * fq;
#pragma unroll
        for (int ai = 0; ai < 2; ++ai)
#pragma unroll
            for (int m = 0; m < 4; ++m) {
                const int row = row0 + ai * HALF + m * 16; const size_t off = (size_t)row * D + col0; float ss = 0.f;
#pragma unroll
                for (int bj = 0; bj < 2; ++bj)
#pragma unroll
                    for (int n = 0; n < 2; ++n) {
                        f32x4 hv = *(const f32x4*)(base + off + bj * HALF + n * 16); hv = hv + acc[ai][bj][m][n];
                        *(f32x4*)(h + off + bj * HALF + n * 16) = hv;
                        u32x2 w; w.x = cvt_pk_bf16(hv[0], hv[1]); w.y = cvt_pk_bf16(hv[2], hv[3]); *(u32x2*)(hb + off + bj * HALF + n * 16) = w;
                        ss += (hv[0] * hv[0] + hv[1] * hv[1]) + (hv[2] * hv[2] + hv[3] * hv[3]);
                    }
                ss += __shfl_xor(ss, 16); ss += __shfl_xor(ss, 32);
                if (fq == 0) ssqp[(size_t)row * 16 + u.pn * 4 + wc] = ss;
                asm volatile("" ::: "memory");
            }
    }
};
struct EpiMoe1 {
    static constexpr bool PERM = true;
    bf16* hid; const int* list; const float* rsc; const float* gatew;
    __device__ __forceinline__ void operator()(const f32x4 (&acc)[2][2][4][2], const Unit& u, int wr, int wc, int fr, int fq) const {
        const int f0 = u.pn * 128 + wc * 16 + 4 * fq;
#pragma unroll
        for (int ai = 0; ai < 2; ++ai)
#pragma unroll
            for (int m = 0; m < 4; ++m) {
                const int r = ai * HALF + wr * 64 + m * 16 + fr; const bool valid = r < u.rows;
                const int slot = list[u.e * LCAP + u.pm * BM + (valid ? r : u.rows - 1)];
                const float sc = rsc[slot], gw = gatew[slot];
#pragma unroll
                for (int bj = 0; bj < 2; ++bj) {
                    const f32x4 g = acc[ai][bj][m][0] * sc, up = acc[ai][bj][m][1] * sc; f32x4 o;
#pragma unroll
                    for (int j = 0; j < 4; ++j) o[j] = g[j] * __builtin_amdgcn_rcpf(1.0f + __expf(-g[j])) * up[j] * gw;
                    u32x2 w; w.x = cvt_pk_bf16(o[0], o[1]); w.y = cvt_pk_bf16(o[2], o[3]);
                    if (valid) *(u32x2*)(hid + (size_t)slot * 512 + f0 + bj * 64) = w;
                }
            }
    }
};
struct EpiMoe2 {
    static constexpr bool PERM = true;
    bf16* ys; const int* list;
    __device__ __forceinline__ void operator()(const f32x4 (&acc)[2][2][4][2], const Unit& u, int wr, int wc, int fr, int fq) const {
        const int col0 = u.pn * BM + wc * 32 + 8 * fq;
#pragma unroll
        for (int ai = 0; ai < 2; ++ai)
#pragma unroll
            for (int m = 0; m < 4; ++m) {
                const int r = ai * HALF + wr * 64 + m * 16 + fr; const bool valid = r < u.rows;
                const int slot = list[u.e * LCAP + u.pm * BM + (valid ? r : u.rows - 1)];
#pragma unroll
                for (int bj = 0; bj < 2; ++bj) {
                    const f32x4 v0 = acc[ai][bj][m][0], v1 = acc[ai][bj][m][1];
                    u32x4 w; w.x = cvt_pk_bf16(v0[0], v0[1]); w.y = cvt_pk_bf16(v0[2], v0[3]); w.z = cvt_pk_bf16(v1[0], v1[1]); w.w = cvt_pk_bf16(v1[2], v1[3]);
                    if (valid) *(u32x4*)(ys + (size_t)slot * D + col0 + bj * HALF) = w;
                }
            }
    }
};
}


namespace att {
constexpr int SHM_T = 16384;
constexpr int OFF_V = 0, OFF_K = 2 * SHM_T, OFF_WS = 4 * SHM_T, OFF_TAB = 4 * SHM_T + 4096;
#define ATT_KSWZ(row, colB) ((row) * 256 + ((colB) ^ (((row) & 7) << 4)))
__device__ __forceinline__ int crow(int r, int hi) { return (r & 3) + 8 * (r >> 2) + 4 * hi; }
__device__ __forceinline__ int v_st(int k, int c) { const int kk = (k & ~0xC) | ((k & 4) << 1) | ((k & 8) >> 1); return ((kk >> 3) * 4 + (c >> 5)) * 512 + ((kk & 7) * 32 + (c & 31)) * 2; }
__device__ __forceinline__ int v_rd_base(int lane) { return ((lane & 3) << 3) | (((lane >> 2) & 3) << 6) | (((lane >> 4) & 1) << 5) | (((lane >> 5) & 1) << 8); }
constexpr int v_rd_off(int d0, int ks, int half) { return d0 * 512 + ks * 4096 + half * 2048; }
typedef short s16x4 __attribute__((ext_vector_type(4)));
template <int OFF> __device__ __forceinline__ s16x4 tr_read(int vb) {
    s16x4 r; asm volatile("ds_read_b64_tr_b16 %0, %1 offset:%2" : "=&v"(r) : "v"(vb), "i"(OFF) : "memory"); return r;
}
template <int D0> __device__ __forceinline__ void pv_one(f32x16& od, int vb, bf16x8 pa0, bf16x8 pa1, bf16x8 pa2, bf16x8 pa3) {
    const s16x4 l0 = tr_read<v_rd_off(D0, 0, 0)>(vb), h0 = tr_read<v_rd_off(D0, 0, 1)>(vb), l1 = tr_read<v_rd_off(D0, 1, 0)>(vb), h1 = tr_read<v_rd_off(D0, 1, 1)>(vb);
    const s16x4 l2 = tr_read<v_rd_off(D0, 2, 0)>(vb), h2 = tr_read<v_rd_off(D0, 2, 1)>(vb), l3 = tr_read<v_rd_off(D0, 3, 0)>(vb), h3 = tr_read<v_rd_off(D0, 3, 1)>(vb);
    asm volatile("s_waitcnt lgkmcnt(0)" ::: "memory"); __builtin_amdgcn_sched_barrier(0);
#define ATT_PK(L, H) (bf16x8){L[0], L[1], L[2], L[3], H[0], H[1], H[2], H[3]}
    od = __builtin_amdgcn_mfma_f32_32x32x16_bf16(pa0, ATT_PK(l0, h0), od, 0, 0, 0);
    od = __builtin_amdgcn_mfma_f32_32x32x16_bf16(pa1, ATT_PK(l1, h1), od, 0, 0, 0);
    od = __builtin_amdgcn_mfma_f32_32x32x16_bf16(pa2, ATT_PK(l2, h2), od, 0, 0, 0);
    od = __builtin_amdgcn_mfma_f32_32x32x16_bf16(pa3, ATT_PK(l3, h3), od, 0, 0, 0);
#undef ATT_PK
}
template <int DK16, int DV32, bool MASK, int HALFWIN, class P>
__device__ __forceinline__ void attn_unit(LAS unsigned char* lds, const P& c, const int ntiles, const float C) {
    const int tid = otid(), wid = __builtin_amdgcn_readfirstlane(tid >> 6), lane = tid & 63, r32 = lane & 31, hi = lane >> 5;
    LAS unsigned char* V_lds = lds + OFF_V; LAS unsigned char* K_lds = lds + OFF_K;
    LAS float* wsf = (LAS float*)(lds + OFF_WS) + wid * 64; LAS float* li_l = wsf; LAS float* al_l = wsf + 32;
    bf16x8 qr[DK16];
    { const bf16* qp = c.q_ptr(wid, r32) + hi * 8;
#pragma unroll
      for (int d0 = 0; d0 < DK16; ++d0) qr[d0] = *(const bf16x8*)(qp + d0 * 16); }
    float m_reg = c.m0(wid), l_reg = c.l0(wid);
    f32x16 o[DV32];
#pragma unroll
    for (int d = 0; d < DV32; ++d)
#pragma unroll
        for (int r = 0; r < 16; ++r) o[d][r] = 0.f;
    constexpr bool D128 = (DK16 == 8);
    const int sr = D128 ? (tid >> 4) : (tid >> 3), sc = D128 ? (tid & 15) * 8 : (tid & 7) * 8;
    const int vst0 = v_st(sr, sc), vst1 = v_st(32 + sr, sc), kst0 = ATT_KSWZ(sr, sc * 2), kst1 = ATT_KSWZ(32 + sr, sc * 2);
    const int vb0 = (int)(unsigned)(uintptr_t)V_lds + v_rd_base(lane);
    bf16x8 ks0, ks1, vs0, vs1;
#define ATT_LOAD(t) do { const int _j = 64 * (t) + sr; ks0 = *(const bf16x8*)(c.k_ptr(_j) + sc); vs0 = *(const bf16x8*)(c.v_ptr(_j) + sc); \
        if (D128) { ks1 = *(const bf16x8*)(c.k_ptr(_j + 32) + sc); vs1 = *(const bf16x8*)(c.v_ptr(_j + 32) + sc); } } while (0)
#define ATT_WRITE(b) do { *(LAS bf16x8*)(V_lds + (b) * SHM_T + vst0) = vs0; *(LAS bf16x8*)(K_lds + (b) * SHM_T + kst0) = ks0; \
        if (D128) { *(LAS bf16x8*)(V_lds + (b) * SHM_T + vst1) = vs1; *(LAS bf16x8*)(K_lds + (b) * SHM_T + kst1) = ks1; } } while (0)
    ATT_LOAD(0); ATT_WRITE(0); __syncthreads();
    for (int t = 0; t < ntiles; ++t) {
        const int b = t & 1;
        if (t + 1 < ntiles) ATT_LOAD(t + 1);
        if (c.active(wid, t)) {
            f32x16 p0, p1;
#pragma unroll
            for (int r = 0; r < 16; ++r) { p0[r] = 0.f; p1[r] = 0.f; }
            const LAS unsigned char* Ks = K_lds + b * SHM_T;
#pragma unroll
            for (int d0 = 0; d0 < DK16; ++d0) { const int cb = (d0 * 16 + hi * 8) * 2;
                const bf16x8 b0 = *(const LAS bf16x8*)(Ks + ATT_KSWZ(r32, cb)); const bf16x8 b1 = *(const LAS bf16x8*)(Ks + ATT_KSWZ(32 + r32, cb));
                p0 = __builtin_amdgcn_mfma_f32_32x32x16_bf16(b0, qr[d0], p0, 0, 0, 0);
                p1 = __builtin_amdgcn_mfma_f32_32x32x16_bf16(b1, qr[d0], p1, 0, 0, 0); }
            if constexpr (MASK) {
                const int db = c.dbase(wid, r32, t) + 4 * hi, qi = c.qidx(wid, r32); const unsigned L = (unsigned)c.seqlen();
                const LAS float* tb = c.tab(wid) + (db + HALFWIN);
#pragma unroll
                for (int r = 0; r < 16; ++r) { const int dc = (r & 3) + 8 * (r >> 2);
                    { const int d = db + dc; const bool ok = ((unsigned)(d + HALFWIN) <= (unsigned)(2 * HALFWIN)) && ((unsigned)(qi + d) < L); const float tv = tb[dc];
                      p0[r] = ok ? fmaf(p0[r], C, tv) : -__builtin_inff(); }
                    { const int d = db + dc + 32; const bool ok = ((unsigned)(d + HALFWIN) <= (unsigned)(2 * HALFWIN)) && ((unsigned)(qi + d) < L); const float tv = tb[dc + 32];
                      p1[r] = ok ? fmaf(p1[r], C, tv) : -__builtin_inff(); } }
            } else {
#pragma unroll
                for (int r = 0; r < 16; ++r) { p0[r] *= C; p1[r] *= C; }
            }
            float pmax = p0[0];
#pragma unroll
            for (int r = 1; r < 16; ++r) pmax = fmaxf(pmax, p0[r]);
#pragma unroll
            for (int r = 0; r < 16; ++r) pmax = fmaxf(pmax, p1[r]);
            { auto rr = __builtin_amdgcn_permlane32_swap(__float_as_uint(pmax), __float_as_uint(pmax), false, false);
              pmax = fmaxf(__uint_as_float(rr[0]), __uint_as_float(rr[1])); }
            const float mn = fmaxf(m_reg, pmax), alpha = __builtin_amdgcn_exp2f(m_reg - mn); m_reg = mn;
            float ps = 0.f;
#pragma unroll
            for (int r = 0; r < 16; ++r) { p0[r] = __builtin_amdgcn_exp2f(p0[r] - mn); p1[r] = __builtin_amdgcn_exp2f(p1[r] - mn); ps += p0[r] + p1[r]; }
            { auto rr = __builtin_amdgcn_permlane32_swap(__float_as_uint(ps), __float_as_uint(ps), false, false);
              ps = __uint_as_float(rr[0]) + __uint_as_float(rr[1]); }
            l_reg = l_reg * alpha + ps;
            bf16x8 pa0, pa1, pa2, pa3;
#define ATT_PK4(Pv, BASE, OUT) do { const unsigned a0 = cvt_pk_bf16(Pv[BASE + 0], Pv[BASE + 1]), a1 = cvt_pk_bf16(Pv[BASE + 2], Pv[BASE + 3]); \
        const unsigned b0_ = cvt_pk_bf16(Pv[BASE + 4], Pv[BASE + 5]), b1_ = cvt_pk_bf16(Pv[BASE + 6], Pv[BASE + 7]); \
        auto r0 = __builtin_amdgcn_permlane32_swap(a0, b0_, false, false); auto r1 = __builtin_amdgcn_permlane32_swap(a1, b1_, false, false); \
        u32x4 w = {r0[0], r1[0], r0[1], r1[1]}; OUT = *reinterpret_cast<bf16x8*>(&w); } while (0)
            ATT_PK4(p0, 0, pa0); ATT_PK4(p0, 8, pa1); ATT_PK4(p1, 0, pa2); ATT_PK4(p1, 8, pa3);
#undef ATT_PK4
            if (__any(alpha < 1.f)) { if (hi == 0) al_l[r32] = alpha; asm volatile("s_waitcnt lgkmcnt(0)" ::: "memory");
#pragma unroll
                for (int r = 0; r < 16; ++r) { const float a = al_l[crow(r, hi)];
#pragma unroll
                    for (int d = 0; d < DV32; ++d) o[d][r] *= a; } }
            const int vb = vb0 + b * SHM_T;
            pv_one<0>(o[0], vb, pa0, pa1, pa2, pa3); pv_one<1>(o[1], vb, pa0, pa1, pa2, pa3);
            if constexpr (DV32 == 4) { pv_one<2>(o[2], vb, pa0, pa1, pa2, pa3); pv_one<3>(o[3], vb, pa0, pa1, pa2, pa3); }
        }
        if (t + 1 < ntiles) ATT_WRITE((t + 1) & 1);
        __syncthreads();
    }
#undef ATT_LOAD
#undef ATT_WRITE
    if (hi == 0) li_l[r32] = l_reg; asm volatile("s_waitcnt lgkmcnt(0)" ::: "memory");
    if (hi == 0) c.lse_store(wid, r32, (m_reg + __builtin_amdgcn_logf(l_reg)) * 0.6931471805599453f);
#pragma unroll
    for (int r = 0; r < 16; ++r) { const int orow = crow(r, hi); const float rl = __builtin_amdgcn_rcpf(li_l[orow]); bf16* op = c.out_ptr(wid, orow) + r32;
#pragma unroll
        for (int d = 0; d < DV32; ++d) op[d * 32] = f2bf(o[d][r] * rl); }
    asm volatile("s_waitcnt lgkmcnt(0)" ::: "memory");
}
#undef ATT_KSWZ

struct XattP {
    const bf16* qx; const bf16* kv; bf16* ox; int q0, h;
    __device__ __forceinline__ const bf16* q_ptr(int w, int r32) const { return qx + (size_t)(q0 + 32 * w + r32) * 512 + h * 128; }
    __device__ __forceinline__ const bf16* k_ptr(int j) const { return kv + (size_t)j * 1024 + h * 128; }
    __device__ __forceinline__ const bf16* v_ptr(int j) const { return kv + (size_t)j * 1024 + 512 + h * 128; }
    __device__ __forceinline__ bool active(int, int) const { return true; }
    __device__ __forceinline__ int dbase(int, int, int) const { return 0; }
    __device__ __forceinline__ int qidx(int, int) const { return 0; }
    __device__ __forceinline__ int seqlen() const { return 0; }
    __device__ __forceinline__ float m0(int) const { return -1e30f; }
    __device__ __forceinline__ float l0(int) const { return 0.f; }
    __device__ __forceinline__ const LAS float* tab(int) const { return nullptr; }
    __device__ __forceinline__ bf16* out_ptr(int w, int row) const { return ox + (size_t)(q0 + 32 * w + row) * 512 + h * 128; }
    __device__ __forceinline__ void lse_store(int, int, float) const {}
};
struct DattP {
    bf16* z; float* lse; const LAS float* tb; int g, h, dil, r, i0, L;
    __device__ __forceinline__ size_t rowoff(int idx) const { return (size_t)(idx * dil + r) * ODD_IN + g * 3072 + h * 128; }
    __device__ __forceinline__ const bf16* q_ptr(int w, int r32) const { return z + rowoff(i0 + 32 * w + r32); }
    __device__ __forceinline__ int kidx(int j) const { int jj = i0 - 64 + j; jj = jj < 0 ? 0 : jj; return jj > L - 1 ? L - 1 : jj; }
    __device__ __forceinline__ const bf16* k_ptr(int j) const { return z + rowoff(kidx(j)) + 1024; }
    __device__ __forceinline__ const bf16* v_ptr(int j) const { return z + rowoff(kidx(j)) + 2048; }
    __device__ __forceinline__ bool active(int w, int t) const { return t >= (w >> 1) && t <= (w >> 1) + 2; }
    __device__ __forceinline__ int dbase(int w, int r32, int t) const { return 64 * t - 64 - 32 * w - r32; }
    __device__ __forceinline__ int qidx(int w, int r32) const { return i0 + 32 * w + r32; }
    __device__ __forceinline__ int seqlen() const { return L; }
    __device__ __forceinline__ float m0(int) const { return -1e30f; }
    __device__ __forceinline__ float l0(int) const { return 0.f; }
    __device__ __forceinline__ const LAS float* tab(int) const { return tb; }
    __device__ __forceinline__ bf16* out_ptr(int w, int row) const { return z + rowoff(i0 + 32 * w + row); }
    __device__ __forceinline__ void lse_store(int w, int row, float v) const { lse[((size_t)g * S + (size_t)(i0 + 32 * w + row) * dil + r) * 8 + h] = v; }
};
struct WattP {
    const bf16* z; bf16* y; const LAS float* tb; const float* sink; int kv, q0;
    __device__ __forceinline__ const bf16* q_ptr(int w, int r32) const { return z + (size_t)(q0 + 32 * (w >> 2) + r32) * EVEN_IN + 1024 + (kv * 4 + (w & 3)) * 64; }
    __device__ __forceinline__ int kpos(int j) const { int jj = q0 - 128 + j; jj = jj < 0 ? 0 : jj; return jj > S - 1 ? S - 1 : jj; }
    __device__ __forceinline__ const bf16* k_ptr(int j) const { return z + (size_t)kpos(j) * EVEN_IN + 1536 + kv * 64; }
    __device__ __forceinline__ const bf16* v_ptr(int j) const { return z + (size_t)kpos(j) * EVEN_IN + 1664 + kv * 64; }
    __device__ __forceinline__ bool active(int, int) const { return true; }
    __device__ __forceinline__ int dbase(int w, int r32, int t) const { return 64 * t - 128 - 32 * (w >> 2) - r32; }
    __device__ __forceinline__ int qidx(int w, int r32) const { return q0 + 32 * (w >> 2) + r32; }
    __device__ __forceinline__ int seqlen() const { return S; }
    __device__ __forceinline__ float m0(int w) const { return sink[kv * 4 + (w & 3)] * 1.4426950408889634f; }
    __device__ __forceinline__ float l0(int) const { return 1.f; }
    __device__ __forceinline__ const LAS float* tab(int w) const { return tb + (w & 3) * 257; }
    __device__ __forceinline__ bf16* out_ptr(int w, int row) const { return y + (size_t)(q0 + 32 * (w >> 2) + row) * D + 512 + (kv * 4 + (w & 3)) * 64; }
    __device__ __forceinline__ void lse_store(int, int, float) const {}
};
}

template <class RM>
__device__ __forceinline__ void cvt_item(const float* W, int N, int K, const float* g, bf16* WT, RM rowmap, LAS float* scr, int kb, int nb, int lane) {
    const int k0 = 64 * kb, n0 = 32 * nb;
    float v[32];
#pragma unroll
    for (int i = 0; i < 32; ++i) { const int kk = 2 * i + (lane >> 5); v[i] = W[(size_t)(k0 + kk) * N + n0 + (lane & 31)]; }
    if (g) {
#pragma unroll
        for (int i = 0; i < 32; ++i) v[i] *= g[k0 + 2 * i + (lane >> 5)];
    }
#pragma unroll
    for (int i = 0; i < 32; ++i) { const int kk = 2 * i + (lane >> 5); scr[kk * 33 + (lane & 31)] = v[i]; }
    asm volatile("s_waitcnt lgkmcnt(0)" ::: "memory");
    const int c = lane & 7;
#pragma unroll
    for (int j = 0; j < 4; ++j) { const int n = (lane >> 3) + 8 * j; const LAS float* s = scr + (8 * c) * 33 + n;
        u32x4 o; o.x = cvt_pk_bf16(s[0 * 33], s[1 * 33]); o.y = cvt_pk_bf16(s[2 * 33], s[3 * 33]); o.z = cvt_pk_bf16(s[4 * 33], s[5 * 33]); o.w = cvt_pk_bf16(s[6 * 33], s[7 * 33]);
        *(u32x4*)(WT + (size_t)rowmap(n0 + n) * K + k0 + 8 * c) = o; }
    asm volatile("s_waitcnt lgkmcnt(0)" ::: "memory");
}
struct CvtCtx { int gw, NGW, base, lane; LAS float* scr; };
template <class RM>
__device__ __forceinline__ void cvt_matrix(CvtCtx& c, const float* W, int K, int N, const float* g, bf16* WT, RM rowmap) {
    const int nblk = N / 32, nitems = (K / 64) * nblk;
    int j0 = (c.gw - c.base) % c.NGW; if (j0 < 0) j0 += c.NGW;
    for (int j = j0; j < nitems; j += c.NGW) cvt_item(W, N, K, g, WT, rowmap, c.scr, j / nblk, j % nblk, c.lane);
    c.base = (c.base + nitems) % c.NGW;
}

__device__ __forceinline__ void rms_row_bf16(const float4 (&v)[4], float rs, const float* g, bf16* dst, int lane) {
#pragma unroll
    for (int j = 0; j < 4; ++j) { const float4 gg = g ? ((const float4*)g)[lane + 64 * j] : make_float4(1.f, 1.f, 1.f, 1.f);
        u32x2 w; w.x = cvt_pk_bf16(v[j].x * rs * gg.x, v[j].y * rs * gg.y); w.y = cvt_pk_bf16(v[j].z * rs * gg.z, v[j].w * rs * gg.w); ((u32x2*)dst)[lane + 64 * j] = w; }
}

enum Phase { PH_INIT = 0, PH_EXPCVT, PH_GEMM1, PH_SGU1, PH_SGU2, PH_WATT, PH_DATT, PH_COMB, PH_GEMM2, PH_GEMM3, PH_XATT, PH_GEMM4, PH_ROUTE, PH_MOE1, PH_MOE2, PH_FIN };

template <int PH>
__device__ __forceinline__ void run_phase(const Params& p, int layer, LAS unsigned char* lds) {
    unsigned char* ws = p.ws;
    asm volatile("" : "+s"(ws), "+s"(layer));
    float* h = (float*)(ws + WS_H); bf16* hb = (bf16*)(ws + WS_HB); bf16* y = (bf16*)(ws + WS_Y); bf16* z = (bf16*)(ws + WS_Z);
    bf16* wnx = (bf16*)(ws + WS_WNX); bf16* wex = (bf16*)(ws + WS_WEX);
    float* bte = (float*)(ws + WS_MISC + MISC_BTE); float* bto = (float*)(ws + WS_MISC + MISC_BTO);
    bf16* memn = (bf16*)(ws + WS_MISC + MISC_MEMN); bf16* kvm = (bf16*)(ws + WS_MISC + MISC_KV);
    int* lists = (int*)(ws + WS_MISC + MISC_LIST); float* gatew = (float*)(ws + WS_MISC + MISC_GW); float* rsc = (float*)(ws + WS_MISC + MISC_RSC);
    float* ssqp = (float*)(ws + WS_MISC + MISC_SSQ);
    bf16* qx = (bf16*)(ws + WS_Z + Z_QX); bf16* ox = (bf16*)(ws + WS_Z + Z_OX); bf16* hid = (bf16*)(ws + WS_Z + Z_HID); bf16* ys = (bf16*)(ws + WS_Z + Z_YS); float* vn = (float*)(ws + WS_Z + Z_VN);
    unsigned* ctl = (unsigned*)(ws + WS_CTL);
    const int tid = otid(), lane = tid & 63, wv = tid >> 6; const int bid = obid();
    const int gtid = bid * NT + tid, GT = gridDim.x * NT;
    const int gw = bid * (NT / 64) + wv, NGW = gridDim.x * (NT / 64);
    const int il = layer >> 1;
    const bool even = (layer & 1) == 0;
    const int G = gridDim.x;

    if constexpr (PH == PH_INIT) {
        for (int i = gtid; i < 8 * 257; i += GT) { const int hh = i / 257, rel = i % 257 - 128; bte[i] = p.rel_table[t5_bucket(rel) * 8 + hh]; }
        for (int i = gtid; i < 3 * 8 * 129; i += GT) { const int g = i / (8 * 129), hh = (i / 129) % 8, j = i % 129 - 64; const int dil = g == 0 ? 1 : (g == 1 ? 4 : 16); bto[i] = p.rel_table[t5_bucket(j * dil) * 8 + hh]; }
        for (int r = gw; r < S; r += NGW) {
            const float4* s4 = (const float4*)(p.x + (size_t)r * D); float4 v[4]; float ss = 0.f;
#pragma unroll
            for (int j = 0; j < 4; ++j) { v[j] = s4[lane + 64 * j]; ss += v[j].x * v[j].x + v[j].y * v[j].y + v[j].z * v[j].z + v[j].w * v[j].w; }
            ss = wave_sum(ss);
            rms_row_bf16(v, 1.0f, nullptr, hb + (size_t)r * D, lane);
            if (lane < 16) ssqp[(size_t)r * 16 + lane] = lane == 0 ? ss : 0.f;
        }
        for (int r = gw; r < MEM; r += NGW) {
            const float4* s4 = (const float4*)(p.mem + (size_t)r * D); float4 v[4]; float ss = 0.f;
#pragma unroll
            for (int j = 0; j < 4; ++j) { v[j] = s4[lane + 64 * j]; ss += v[j].x * v[j].x + v[j].y * v[j].y + v[j].z * v[j].z + v[j].w * v[j].w; }
            const float rs = rsqrtf(wave_sum(ss) * (1.0f / D) + 1e-6f);
            for (int l = 0; l < DEPTH; ++l) rms_row_bf16(v, rs, p.ln_mem + l * D, memn + ((size_t)l * MEM + r) * D, lane);
        }
        CvtCtx c{gw, NGW, 0, lane, (LAS float*)(lds + wv * 16384)};
        auto idm = [](int n) { return n; };
        for (int i = 0; i < 2; ++i) {
            cvt_matrix(c, p.even_w_in + (size_t)i * D * EVEN_IN, D, EVEN_IN, p.ln_mix + (2 * i) * D, wnx + WO_W1E + i * W1E_SZ, idm);
            cvt_matrix(c, p.even_w_out + (size_t)i * D * D, D, D, nullptr, wnx + WO_W2E + i * W2_SZ, idm);
            cvt_matrix(c, p.odd_w_in + (size_t)i * D * ODD_IN, D, ODD_IN, p.ln_mix + (2 * i + 1) * D, wnx + WO_W1O + i * W1O_SZ, idm);
            cvt_matrix(c, p.odd_w_out + (size_t)i * D * D, D, D, nullptr, wnx + WO_W2O + i * W2_SZ, idm);
        }
        for (int l = 0; l < DEPTH; ++l) {
            cvt_matrix(c, p.xq_w + (size_t)l * D * 512, D, 512, p.ln_cross + l * D, wnx + WO_WQ + l * WQ_SZ, idm);
            cvt_matrix(c, p.xkv_w + (size_t)l * D * 1024, D, 1024, nullptr, wnx + WO_WKV + l * WKV_SZ, idm);
            cvt_matrix(c, p.xo_w + (size_t)l * 512 * D, 512, D, nullptr, wnx + WO_WO + l * WO_SZ, idm);
        }
    }
    if constexpr (PH == PH_EXPCVT) {
        CvtCtx c{gw, NGW, 0, lane, (LAS float*)(lds + wv * 16384)};
        const float* gf = p.ln_ffn + layer * D;
        for (int e = 0; e < 16; ++e) {
            cvt_matrix(c, p.ewg + ((size_t)layer * 16 + e) * D * 512, D, 512, gf, wex + e * WGU_SZ, [](int n) { return 8 * (n >> 2) + (n & 3); });
            cvt_matrix(c, p.ewu + ((size_t)layer * 16 + e) * D * 512, D, 512, gf, wex + e * WGU_SZ, [](int n) { return 8 * (n >> 2) + 4 + (n & 3); });
            cvt_matrix(c, p.ewd + ((size_t)layer * 16 + e) * 512 * D, 512, D, nullptr, wex + WEX_WD + e * WD_SZ, [](int n) { return n; });
        }
    }
    if constexpr (PH == PH_GEMM1) {
        const int N = even ? EVEN_IN : ODD_IN;
        const bf16* W = even ? wnx + WO_W1E + il * W1E_SZ : wnx + WO_W1O + il * W1O_SZ;
        pg8::DenseSched Sd; Sd.init(S, N, D, W, G, bid);
        pg8::EpiScaleBf16 E{z, N, ssqp, even ? 4 : 0};
        pg8::gemm_phase(lds, hb, D, Sd, E);
        if (layer == 0 && bid >= G - 16) {
            const int uidx = bid - (G - 16), l = uidx >> 2;
            pg8::DenseSched Sk; Sk.init(MEM, 1024, D, wnx + WO_WKV + l * WKV_SZ, 4, uidx & 3);
            pg8::EpiScaleBf16 Ek{kvm + (size_t)l * MEM * 1024, 1024, nullptr, 0};
            pg8::gemm_phase(lds, memn + (size_t)l * MEM * D, D, Sk, Ek);
        }
    }
    if constexpr (PH == PH_SGU1) {
        const float* lg = p.sgu_ln_g + il * 512; const float* lb = p.sgu_ln_b + il * 512;
        for (int t = gw; t < S; t += NGW) {
            float v[8]; float s = 0.f;
#pragma unroll
            for (int j = 0; j < 8; ++j) { v[j] = bf2f(z[(size_t)t * EVEN_IN + 512 + lane + 64 * j]); s += v[j]; }
            const float mu = wave_sum(s) * (1.f / 512.f); float q = 0.f;
#pragma unroll
            for (int j = 0; j < 8; ++j) { v[j] -= mu; q += v[j] * v[j]; }
            const float rstd = rsqrtf(wave_sum(q) * (1.f / 512.f) + 1e-6f);
#pragma unroll
            for (int j = 0; j < 8; ++j) { const int c = lane + 64 * j; vn[(size_t)t * 512 + c] = v[j] * rstd * lg[c] + lb[c]; }
        }
    }
    if constexpr (PH == PH_SGU2) {
        const float* wsg = p.sgu_w + (size_t)il * 4 * 128 * 128; const float* bs = p.sgu_b + il * 4 * 128;
        for (size_t i = gtid; i < (size_t)S * 512; i += GT) {
            const int t = (int)(i >> 9), ch = (int)(i & 511), g = ch >> 7, pp = t & 127, n0 = t & ~127;
            const float* wr = wsg + ((size_t)g * 128 + pp) * 128; float acc = 0.f;
            for (int q = 0; q < 128; ++q) acc += wr[q] * vn[(size_t)(n0 + q) * 512 + ch];
            acc += bs[g * 128 + pp];
            y[(size_t)t * D + ch] = f2bf(bf2f(z[(size_t)t * EVEN_IN + ch]) * acc);
        }
    }
    if constexpr (PH == PH_WATT) {
        LAS float* tb = (LAS float*)(lds + att::OFF_TAB);
        for (int u = bid; u < (S / 64) * 2; u += G) {
            const int kv = u & 1, blk = u >> 1;
            for (int i = tid; i < 4 * 257; i += NT) tb[i] = bte[(kv * 4 + i / 257) * 257 + i % 257] * 1.4426950408889634f;
            att::WattP P{z, y, tb, p.attn_sink + il * 8, kv, blk * 64};
            att::attn_unit<4, 2, true, 128>(lds, P, 5, 0.125f * 1.4426950408889634f);
        }
    }
    if constexpr (PH == PH_DATT) {
        float* lse = (float*)(ws + WS_MISC + MISC_LSE);
        LAS float* tb = (LAS float*)(lds + att::OFF_TAB);
        for (int u = bid; u < 3 * 512; u += G) {
            const int g = u >> 9, uu = u & 511, hh = uu & 7, rest = uu >> 3;
            const int dil = g == 0 ? 1 : (g == 1 ? 4 : 16), r = rest % dil, blk = rest / dil;
            if (tid < 129) tb[tid] = bto[(g * 8 + hh) * 129 + tid] * 1.4426950408889634f;
            att::DattP P{z, lse, tb, g, hh, dil, r, blk * 256, S / dil};
            att::attn_unit<8, 4, true, 64>(lds, P, 6, 0.08838834764831845f * 1.4426950408889634f);
        }
    }
    if constexpr (PH == PH_COMB) {
        const float* lse = (const float*)(ws + WS_MISC + MISC_LSE);
        for (int i = gtid; i < S * 128; i += GT) {
            const int pos = i >> 7, ch = i & 127, hh = ch >> 4;
            const float l0 = lse[((size_t)0 * S + pos) * 8 + hh], l1 = lse[((size_t)1 * S + pos) * 8 + hh], l2 = lse[((size_t)2 * S + pos) * 8 + hh];
            const float mx = fmaxf(l0, fmaxf(l1, l2)); float w0 = __expf(l0 - mx), w1 = __expf(l1 - mx), w2 = __expf(l2 - mx); const float inv = 1.0f / (w0 + w1 + w2); w0 *= inv; w1 *= inv; w2 *= inv;
            const bf16* zr = z + (size_t)pos * ODD_IN + ch * 8;
            const u32x4 a = *(const u32x4*)zr, b = *(const u32x4*)(zr + 3072), c = *(const u32x4*)(zr + 6144); u32x4 o;
#pragma unroll
            for (int k = 0; k < 4; ++k) {
                const float lo = w0 * __uint_as_float(a[k] << 16) + w1 * __uint_as_float(b[k] << 16) + w2 * __uint_as_float(c[k] << 16);
                const float hi2 = w0 * __uint_as_float(a[k] & 0xffff0000u) + w1 * __uint_as_float(b[k] & 0xffff0000u) + w2 * __uint_as_float(c[k] & 0xffff0000u);
                o[k] = cvt_pk_bf16(lo, hi2); }
            *(u32x4*)(y + (size_t)pos * D + ch * 8) = o;
        }
    }
    if constexpr (PH == PH_GEMM2) {
        const bf16* W = even ? wnx + WO_W2E + il * W2_SZ : wnx + WO_W2O + il * W2_SZ;
        pg8::DenseSched Sd; Sd.init(S, D, D, W, G, bid);
        pg8::EpiResidual E{layer == 0 ? p.x : h, h, hb, ssqp};
        pg8::gemm_phase(lds, y, D, Sd, E);
    }
    if constexpr (PH == PH_GEMM3) {
        pg8::DenseSched Sd; Sd.init(S, 512, D, wnx + WO_WQ + layer * WQ_SZ, G, bid);
        pg8::EpiScaleBf16 E{qx, 512, ssqp, 0};
        pg8::gemm_phase(lds, hb, D, Sd, E);
    }
    if constexpr (PH == PH_XATT) {
        const bf16* kvl = kvm + (size_t)layer * MEM * 1024;
        for (int u = bid; u < (S / 256) * 4; u += G) {
            att::XattP P{qx, kvl, ox, (u >> 2) * 256, u & 3};
            att::attn_unit<8, 4, false, 64>(lds, P, 4, 0.08838834764831845f * 1.4426950408889634f);
        }
    }
    if constexpr (PH == PH_GEMM4) {
        pg8::DenseSched Sd; Sd.init(S, D, 512, wnx + WO_WO + layer * WO_SZ, G, bid);
        pg8::EpiResidual E{h, h, hb, ssqp};
        pg8::gemm_phase(lds, ox, 512, Sd, E);
    }
    if constexpr (PH == PH_ROUTE) {
        const float* wg = p.rgw + (size_t)layer * D * 4; const float* we = p.rew + (size_t)layer * D * 16;
        const float* bg = p.rgb + layer * 4; const float* be = p.reb + layer * 16; const float* gf = p.ln_ffn + layer * D;
        for (int t = gw; t < S; t += NGW) {
            float ssq = lane < 16 ? ssqp[(size_t)t * 16 + lane] : 0.f; ssq = wave_sum(ssq);
            const float rs = rsqrtf(ssq * (1.0f / D) + 1e-6f);
            float lg[4], le[16];
#pragma unroll
            for (int c = 0; c < 4; ++c) lg[c] = 0.f;
#pragma unroll
            for (int c = 0; c < 16; ++c) le[c] = 0.f;
            for (int k = lane; k < D; k += 64) {
                const float xv = h[(size_t)t * D + k] * rs * gf[k];
                const float4 g4 = *(const float4*)(wg + (size_t)k * 4);
                lg[0] += xv * g4.x; lg[1] += xv * g4.y; lg[2] += xv * g4.z; lg[3] += xv * g4.w;
#pragma unroll
                for (int c4 = 0; c4 < 4; ++c4) { const float4 e4 = *(const float4*)(we + (size_t)k * 16 + c4 * 4); le[c4 * 4 + 0] += xv * e4.x; le[c4 * 4 + 1] += xv * e4.y; le[c4 * 4 + 2] += xv * e4.z; le[c4 * 4 + 3] += xv * e4.w; }
            }
#pragma unroll
            for (int c = 0; c < 4; ++c) lg[c] = wave_sum(lg[c]) + bg[c];
#pragma unroll
            for (int c = 0; c < 16; ++c) le[c] = wave_sum(le[c]) + be[c];
            if (lane == 0) {
                int grp = 0; float gm = lg[0];
#pragma unroll
                for (int c = 1; c < 4; ++c) if (lg[c] > gm) { gm = lg[c]; grp = c; }
                float gs = 0.f;
#pragma unroll
                for (int c = 0; c < 4; ++c) gs += __expf(lg[c] - gm);
                const float ggate = 1.0f / gs;
                float es[4];
#pragma unroll
                for (int e = 0; e < 4; ++e) es[e] = grp == 0 ? le[e] : (grp == 1 ? le[4 + e] : (grp == 2 ? le[8 + e] : le[12 + e]));
                int i0 = 0; float v0 = es[0];
#pragma unroll
                for (int e = 1; e < 4; ++e) if (es[e] > v0) { v0 = es[e]; i0 = e; }
                int i1 = -1; float v1 = -3.0e38f;
#pragma unroll
                for (int e = 0; e < 4; ++e) if (e != i0 && es[e] > v1) { v1 = es[e]; i1 = e; }
                const float ex = __expf(v1 - v0); const float w0 = 1.0f / (1.0f + ex), w1 = ex / (1.0f + ex);
                const int E0 = grp * 4 + i0, E1 = grp * 4 + i1;
                const unsigned p0 = atomicAdd(&ctl[CW_CNT + (layer * 16 + E0) * 64], 1u);
                const unsigned p1 = atomicAdd(&ctl[CW_CNT + (layer * 16 + E1) * 64], 1u);
                lists[E0 * LCAP + p0] = 2 * t; lists[E1 * LCAP + p1] = 2 * t + 1;
                gatew[2 * t] = ggate * w0; gatew[2 * t + 1] = ggate * w1;
                rsc[2 * t] = rs; rsc[2 * t + 1] = rs;
            }
        }
    }
    if constexpr (PH == PH_MOE1 || PH == PH_MOE2) {
        LAS int* moe = (LAS int*)(lds + LDS_MOE);
        if (tid == 0) { int acc = 0; for (int e = 0; e < 16; ++e) { const int c = (int)ctl[CW_CNT + (layer * 16 + e) * 64]; moe[e] = acc; moe[17 + e] = c; acc += (c + 255) >> 8; } moe[16] = acc; }
        __syncthreads();
        if constexpr (PH == PH_MOE1) {
            pg8::MoeSched<true> Sm{4, G, bid, D, wex, WGU_SZ, lists, moe};
            pg8::EpiMoe1 E{hid, lists, rsc, gatew};
            pg8::gemm_phase(lds, hb, D, Sm, E);
        } else {
            pg8::MoeSched<false> Sm{4, G, bid, 512, wex + WEX_WD, WD_SZ, lists, moe};
            pg8::EpiMoe2 E{ys, lists};
            pg8::gemm_phase(lds, hid, 512, Sm, E);
        }
        __syncthreads();
    }
    if constexpr (PH == PH_FIN) {
        for (int r = gw; r < S; r += NGW) {
            const float4* s4 = (const float4*)(h + (size_t)r * D); float4 v[4]; float ss = 0.f;
            const u32x2* y0 = (const u32x2*)(ys + (size_t)(2 * r) * D); const u32x2* y1 = (const u32x2*)(ys + (size_t)(2 * r + 1) * D);
#pragma unroll
            for (int j = 0; j < 4; ++j) {
                v[j] = s4[lane + 64 * j]; const u32x2 a = y0[lane + 64 * j], b = y1[lane + 64 * j];
                v[j].x += __uint_as_float(a.x << 16) + __uint_as_float(b.x << 16); v[j].y += __uint_as_float(a.x & 0xffff0000u) + __uint_as_float(b.x & 0xffff0000u);
                v[j].z += __uint_as_float(a.y << 16) + __uint_as_float(b.y << 16); v[j].w += __uint_as_float(a.y & 0xffff0000u) + __uint_as_float(b.y & 0xffff0000u);
                ss += v[j].x * v[j].x + v[j].y * v[j].y + v[j].z * v[j].z + v[j].w * v[j].w;
            }
            ss = wave_sum(ss);
            if (layer == DEPTH - 1) {
                const float rs = rsqrtf(ss * (1.0f / D) + 1e-6f); float4* o4 = (float4*)(p.out + (size_t)r * D);
#pragma unroll
                for (int j = 0; j < 4; ++j) { const float4 gg = ((const float4*)p.ln_final)[lane + 64 * j]; float4 o; o.x = v[j].x * rs * gg.x; o.y = v[j].y * rs * gg.y; o.z = v[j].z * rs * gg.z; o.w = v[j].w * rs * gg.w; o4[lane + 64 * j] = o; }
            } else {
                float4* d4 = (float4*)(h + (size_t)r * D);
#pragma unroll
                for (int j = 0; j < 4; ++j) d4[lane + 64 * j] = v[j];
                rms_row_bf16(v, 1.0f, nullptr, hb + (size_t)r * D, lane);
                if (lane < 16) ssqp[(size_t)r * 16 + lane] = lane == 0 ? ss : 0.f;
            }
        }
    }
}

__global__ void __launch_bounds__(NT, 2) k_mega(Params p) {
    extern __shared__ __attribute__((aligned(16))) unsigned char lds_[];
    LAS unsigned char* lds = (LAS unsigned char*)lds_;
    if (threadIdx.x < 4) ((LAS unsigned*)(lds + LDS_BARW))[threadIdx.x] = 0u;
    __syncthreads();
    XcdBarrier bar = xcd_barrier_post((unsigned*)(p.ws + WS_CTL) + CW_BAR, (volatile LAS unsigned*)(lds + LDS_BARW));
#define PHB(PH, l) do { run_phase<PH>(p, l, lds); xcd_barrier(bar); } while (0)
    PHB(PH_INIT, 0);
    for (int l = 0; l < DEPTH; ++l) {
        PHB(PH_GEMM1, l);
        if ((l & 1) == 0) { PHB(PH_SGU1, l); run_phase<PH_SGU2>(p, l, lds); PHB(PH_WATT, l); } else { PHB(PH_DATT, l); PHB(PH_COMB, l); }
        PHB(PH_GEMM2, l); PHB(PH_GEMM3, l); PHB(PH_XATT, l); run_phase<PH_EXPCVT>(p, l, lds); __syncthreads(); PHB(PH_GEMM4, l);
        PHB(PH_ROUTE, l); PHB(PH_MOE1, l); PHB(PH_MOE2, l);
        if (l == DEPTH - 1) run_phase<PH_FIN>(p, l, lds); else PHB(PH_FIN, l);
    }
#undef PHB
}

extern "C" void kernel_launch(void* const* d_in, const int* in_sizes, int n_in, void* d_out, int out_size, void* d_ws, size_t ws_size, hipStream_t stream) {
    if (n_in != 27 || ws_size < WS_END) { fprintf(stderr, "kernel_launch: unexpected n_in %d or ws_size %zu\n", n_in, ws_size); return; }
    Params p{};
    const float** pp = (const float**)&p;
    for (int i = 0; i < 27; ++i) pp[i] = (const float*)d_in[i];
    p.out = (float*)d_out; p.ws = (unsigned char*)d_ws;
    (void)hipMemsetAsync((char*)d_ws + WS_CTL, 0, 1 * MiB, stream);
    static int grid = 0;
    if (grid == 0) {
        int dev = 0, cus = 0, per_cu = 0;
        if (hipGetDevice(&dev) != hipSuccess || hipDeviceGetAttribute(&cus, hipDeviceAttributeMultiprocessorCount, dev) != hipSuccess) { grid = -1; return; }
        if (hipFuncSetAttribute((const void*)k_mega, hipFuncAttributeMaxDynamicSharedMemorySize, LDS_BYTES) != hipSuccess) { fprintf(stderr, "hipFuncSetAttribute failed\n"); grid = -1; return; }
        if (hipOccupancyMaxActiveBlocksPerMultiprocessor(&per_cu, (const void*)k_mega, NT, LDS_BYTES) != hipSuccess || per_cu < 1) { fprintf(stderr, "occupancy query: %d\n", per_cu); grid = -1; return; }
        (void)hipGetLastError();
        grid = cus;
    }
    if (grid < 0) return;
    hipLaunchKernelGGL(k_mega, dim3(grid), dim3(NT), LDS_BYTES, stream, p);
}
```

```cpp
#include <hip/hip_runtime.h>
#include <cstdio>
#include <cstdint>

typedef unsigned short bf16;
#define LAS __attribute__((address_space(3)))
typedef short bf16x8 __attribute__((ext_vector_type(8)));
typedef float f32x4 __attribute__((ext_vector_type(4)));
typedef float f32x16 __attribute__((ext_vector_type(16)));
typedef unsigned u32x4 __attribute__((ext_vector_type(4)));
typedef unsigned u32x2 __attribute__((ext_vector_type(2)));

constexpr int S = 16384, D = 1024, DEPTH = 4, MEM = 256;
constexpr int EVEN_IN = 1792, ODD_IN = 9216;
constexpr int NT = 512;
constexpr int LCAP = 16384;
constexpr size_t MiB = 1u << 20;
constexpr size_t WS_CTL = 0;
constexpr size_t WS_H = 1 * MiB;
constexpr size_t WS_HB = 65 * MiB;
constexpr size_t WS_Y = 97 * MiB;
constexpr size_t WS_Z = 129 * MiB;
constexpr size_t WS_WNX = 417 * MiB;
constexpr size_t WS_WEX = 484 * MiB;
constexpr size_t WS_MISC = 532 * MiB;
constexpr size_t WS_END = 548 * MiB;
constexpr size_t MISC_BTE = 0;
constexpr size_t MISC_BTO = 16384;
constexpr size_t MISC_SGW = 65536;
constexpr size_t MISC_MEMN = 1 * MiB;
constexpr size_t MISC_KV = 3 * MiB;
constexpr size_t MISC_LIST = 5 * MiB;
constexpr size_t MISC_GW = 6 * MiB;
constexpr size_t MISC_RSC = 6 * MiB + 131072;
constexpr size_t MISC_SSQ = 7 * MiB;
constexpr size_t MISC_LSE = 8 * MiB;
constexpr size_t Z_QX = 0;
constexpr size_t Z_OX = 16 * MiB;
constexpr size_t Z_HID = 32 * MiB;
constexpr size_t Z_VN = 64 * MiB;
constexpr size_t Z_YS = 96 * MiB;
constexpr size_t W1E_SZ = (size_t)EVEN_IN * D, W2_SZ = (size_t)D * D, W1O_SZ = (size_t)ODD_IN * D, WQ_SZ = (size_t)512 * D, WKV_SZ = (size_t)1024 * D, WO_SZ = (size_t)D * 512;
constexpr size_t WO_W1E = 0, WO_W2E = WO_W1E + 2 * W1E_SZ, WO_W1O = WO_W2E + 2 * W2_SZ, WO_W2O = WO_W1O + 2 * W1O_SZ, WO_WQ = WO_W2O + 2 * W2_SZ, WO_WKV = WO_WQ + 4 * WQ_SZ, WO_WO = WO_WKV + 4 * WKV_SZ, WO_END = WO_WO + 4 * WO_SZ;
static_assert(WO_END * 2 <= 67 * MiB, "non-expert weights fit");
constexpr size_t WGU_SZ = (size_t)1024 * 1024, WD_SZ = (size_t)1024 * 512;
constexpr size_t WEX_WD = 16 * WGU_SZ;
constexpr int CW_CNT = 1024;
constexpr int CW_BAR = 8192;
constexpr int LDS_BYTES = 147456;
constexpr int LDS_BARW = 131072;
constexpr int LDS_MOE = 131072 + 64;

struct Params {
    const float *x, *mem, *ln_mix, *ln_cross, *ln_mem, *ln_ffn, *ln_final, *rel_table,
        *even_w_in, *even_w_out, *sgu_ln_g, *sgu_ln_b, *sgu_w, *sgu_b, *attn_sink,
        *odd_w_in, *odd_w_out, *xq_w, *xkv_w, *xo_w, *rgw, *rgb, *rew, *reb, *ewg, *ewu, *ewd;
    float* out;
    unsigned char* ws;
};

__device__ __forceinline__ int otid() { int t = threadIdx.x; asm volatile("" : "+v"(t)); return t; }
__device__ __forceinline__ int obid() { int t = blockIdx.x; asm volatile("" : "+s"(t)); return t; }
__device__ __forceinline__ float bf2f(bf16 b) { return __uint_as_float(((unsigned)b) << 16); }
__device__ __forceinline__ bf16 f2bf(float f) { unsigned u = __float_as_uint(f); u += 0x7fffu + ((u >> 16) & 1u); return (bf16)(u >> 16); }
__device__ __forceinline__ unsigned cvt_pk_bf16(float lo, float hi) { unsigned r; asm volatile("v_cvt_pk_bf16_f32 %0, %1, %2" : "=v"(r) : "v"(lo), "v"(hi)); return r; }
__device__ __forceinline__ float wave_sum(float v) {
#pragma unroll
    for (int o = 1; o < 64; o <<= 1) v += __shfl_xor(v, o);
    return v;
}
__device__ __forceinline__ float gelu_tanh(float x) {
    const float u2 = 1.5957691216057308f * (x + 0.044715f * x * x * x);
    return x * __builtin_amdgcn_rcpf(1.0f + __expf(-u2));
}
__device__ __forceinline__ int t5_bucket(int rel) {
    const int ret = rel > 0 ? 16 : 0;
    const int n = rel < 0 ? -rel : rel;
    if (n < 8) return ret + n;
    const float nf = (float)n;
    int large = 8 + (int)(logf(nf / 8.0f) / 4.852030263919617f * 8.0f);
    large = large < 15 ? large : 15;
    return ret + large;
}

#define XB_TMO      128
#define XB_XCNT(j)  (256  + 64 * (j))
#define XB_XSUB(j)  (1280 + 64 * (j))
#define XB_XGEN(j)  (2304 + 64 * (j))
#define XB_TOP      3328
#define XB_TOPGEN   3392
#define XCD_BAR_WORDS 3456
#define XB_SPIN_CAP (1u << 22)
__device__ __forceinline__ unsigned xb_ld(unsigned* p)              { return __hip_atomic_load(p, __ATOMIC_RELAXED, __HIP_MEMORY_SCOPE_AGENT); }
__device__ __forceinline__ unsigned xb_add(unsigned* p, unsigned v) { return __hip_atomic_fetch_add(p, v, __ATOMIC_RELAXED, __HIP_MEMORY_SCOPE_AGENT); }
__device__ __forceinline__ unsigned xb_xcc_id() { return (unsigned)__builtin_amdgcn_s_getreg((3 << 11) | 20) & 0xFu; }
#define XB_SPIN(cond, bar) do { unsigned _sp = 0; while (cond) { __builtin_amdgcn_s_sleep(1); \
    if ((++_sp & 255u) == 0u) { if (xb_ld(&(bar)[XB_TMO])) break; if (_sp > XB_SPIN_CAP) { atomicAdd(&(bar)[XB_TMO], 1u); break; } } } } while (0)
struct XcdBarrier { unsigned* bar; unsigned x; volatile LAS unsigned* st; };
__device__ __forceinline__ XcdBarrier xcd_barrier_post(unsigned* bar, volatile LAS unsigned* st) {
    XcdBarrier b; b.bar = bar; b.x = (unsigned)__builtin_amdgcn_readfirstlane((int)xb_xcc_id()); b.st = st;
    if (threadIdx.x == 0) (void)xb_add(&bar[XB_XCNT(b.x)], 1u);
    return b;
}
__device__ __forceinline__ void xcd_barrier_complete(unsigned* bar, unsigned x, unsigned& nloc, unsigned& nx) {
    const unsigned G = gridDim.x * gridDim.y * gridDim.z;
    unsigned sum, cnt, mine, sp = 0u;
    for (;;) {
        sum = 0u; cnt = 0u; mine = 0u;
#pragma unroll
        for (unsigned j = 0; j < 16; ++j) { const unsigned c = xb_ld(&bar[XB_XCNT(j)]); sum += c; cnt += (c > 0u) ? 1u : 0u; mine = (j == x) ? c : mine; }
        if (sum == G) break;
        __builtin_amdgcn_s_sleep(1);
        if ((++sp & 255u) == 0u) { if (xb_ld(&bar[XB_TMO])) break; if (sp > XB_SPIN_CAP) { atomicAdd(&bar[XB_TMO], 1u); break; } }
    }
    nloc = mine > 0u ? mine : 1u; nx = cnt > 0u ? cnt : 1u;
}
__device__ __forceinline__ void xcd_barrier(const XcdBarrier& b) {
    asm volatile("s_waitcnt vmcnt(0)" ::: "memory");
    __syncthreads();
    if (threadIdx.x == 0) {
        unsigned* bar = b.bar; unsigned bx = b.x; asm volatile("" : "+s"(bar), "+s"(bx));
        __builtin_amdgcn_s_waitcnt(0);
        unsigned nloc = b.st[0], nx = b.st[1];
        if (nloc == 0u) { xcd_barrier_complete(bar, bx, nloc, nx); b.st[0] = nloc; b.st[1] = nx; }
        const unsigned old = xb_add(&bar[XB_XSUB(bx)], 1u);
        const unsigned gen = old / nloc;
        if (old + 1u == (gen + 1u) * nloc) {
            __builtin_amdgcn_fence(__ATOMIC_RELEASE, "agent");
            asm volatile("s_waitcnt vmcnt(0)" ::: "memory");
            const unsigned og = xb_add(&bar[XB_TOP], 1u);
            const unsigned tg = og / nx;
            if (og + 1u == (tg + 1u) * nx) xb_add(&bar[XB_TOPGEN], 1u);
            else XB_SPIN(xb_ld(&bar[XB_TOPGEN]) == tg, bar);
            __builtin_amdgcn_fence(__ATOMIC_ACQUIRE, "agent");
            xb_add(&bar[XB_XGEN(bx)], 1u);
            asm volatile("s_waitcnt vmcnt(0)" ::: "memory");
        } else {
            XB_SPIN(xb_ld(&bar[XB_XGEN(bx)]) == gen, bar);
            __builtin_amdgcn_fence(__ATOMIC_ACQUIRE, "agent");
            asm volatile("s_waitcnt vmcnt(0)" ::: "memory");
        }
    }
    __syncthreads();
}

namespace pg8 {
constexpr int BM = 256, BK = 64, HALF = 128, HTB = HALF * BK * 2, STAGE_BYTES = 8 * HTB, NXCD = 8, WGM = 8;
__host__ __device__ __forceinline__ int lds_byte(int r, int c) { const int st = (r >> 4) * 2 + (c >> 5), rr = r & 15, cc = c & 31, ob = rr * 64 + cc * 2; return st * 1024 + (ob ^ (((ob >> 9) & 1) << 5)); }
__host__ __device__ __forceinline__ void stage_rc(int b, int& R, int& C) { const int st = b / 1024, sb = b % 1024, swz = sb ^ (((sb >> 9) & 1) << 5); R = (st >> 1) * 16 + swz / 64; C = (st & 1) * 32 + (swz % 64) / 2; }
__host__ __device__ __forceinline__ int perm32(int rho) { const int n = rho >> 4, i = rho & 15; return 8 * (i >> 2) + 4 * n + (i & 3); }
struct Unit { int pm, pn, e, rows; };

struct DenseSched {
    int nM, nN, nwg, G, c, K; const bf16* Bt;
    __device__ void init(int M, int N, int K_, const bf16* Bt_, int G_, int c_) { nM = M / BM; nN = N / BM; nwg = nM * nN; G = G_; c = c_; K = K_; Bt = Bt_; }
    __device__ __forceinline__ bool next(int i, Unit& u) const {
        const long L = (long)i * G + c; if (L >= nwg) return false;
        int wgid = (int)L; { const int q = nwg / NXCD, r = nwg % NXCD, xcd = wgid % NXCD, off = wgid / NXCD; wgid = (xcd < r ? xcd * (q + 1) : r * (q + 1) + (xcd - r) * q) + off; }
        const int nig = WGM * nN, gid = wgid / nig, fm = gid * WGM, gsz = (nM - fm) < WGM ? (nM - fm) : WGM;
        u.pm = fm + ((wgid % nig) % gsz); u.pn = (wgid % nig) / gsz; u.e = 0; u.rows = 256; return true;
    }
    __device__ __forceinline__ unsigned arow(const Unit& u, int r) const { return (unsigned)(u.pm * BM + r) * (unsigned)(K * 2); }
    __device__ __forceinline__ const char* bbase(const Unit& u) const { return (const char*)Bt + (size_t)u.pn * BM * K * 2; }
};
template <bool TOKEN_ROWS>
struct MoeSched {
    int nN, G, c, K; const bf16* Bt; size_t bstride; const int* list; const LAS int* moe;
    __device__ __forceinline__ bool next(int i, Unit& u) const {
        const int L = i * G + c; const int total = moe[16] * nN; if (L >= total) return false;
        const int rt = L / nN; u.pn = L % nN; int e = 0;
#pragma unroll
        for (int j = 1; j < 16; ++j) e = (rt >= moe[j]) ? j : e;
        u.e = e; u.pm = rt - moe[e]; const int left = moe[17 + e] - u.pm * BM; u.rows = left < BM ? left : BM; return true;
    }
    __device__ __forceinline__ unsigned arow(const Unit& u, int r) const {
        const int idx = r < u.rows ? r : u.rows - 1; const int slot = list[u.e * LCAP + u.pm * BM + idx];
        return (unsigned)(TOKEN_ROWS ? (slot >> 1) : slot) * (unsigned)(K * 2);
    }
    __device__ __forceinline__ const char* bbase(const Unit& u) const { return (const char*)Bt + ((size_t)u.e * bstride + (size_t)u.pn * BM * K) * 2; }
};

template <class Epi, class Sched>
__device__ __forceinline__ void gemm_phase(LAS unsigned char* lds, const bf16* Abase, const int K, const Sched& S, const Epi& E) {
    const int tid = otid(), wid = __builtin_amdgcn_readfirstlane(tid >> 6), lane = tid & 63, wr = wid >> 2, wc = wid & 3, fr = lane & 15, fq = lane >> 4;
    const int nt = K / BK;
    unsigned voffB[2];
#pragma unroll
    for (int i = 0; i < 2; ++i) { int R, C; stage_rc(tid * 16 + i * 8192, R, C); const int Rb = Epi::PERM ? ((R & ~31) + perm32(R & 31)) : R;
        voffB[i] = (unsigned)(Rb * K + C) * 2u; }
#define PG8_AOFFS(u, o0, o1) do { const int _t = otid(); _Pragma("unroll") for (int _i = 0; _i < 2; ++_i) { int _R, _C; stage_rc(_t * 16 + _i * 8192, _R, _C); \
        o0[_i] = S.arow(u, _R) + (unsigned)_C * 2u; o1[_i] = S.arow(u, HALF + _R) + (unsigned)_C * 2u; } } while (0)
    const size_t kstep = (size_t)(BK * 2);
    const size_t hstep = (size_t)HALF * K * 2;
    const unsigned ldsw = (unsigned)wid * 1024u;
    const int aoff = lds_byte(wr * 64 + fr, fq * 8), boff = lds_byte(wc * 32 + fr, fq * 8);
    const char* Ab = (const char*)Abase;
#define PG8_SA(b, h) (((b) * 2 + (h)) * HTB)
#define PG8_SB(b, h) ((4 + (b) * 2 + (h)) * HTB)
#define PG8_STAGE(bufoff, gbase, voff) do { _Pragma("unroll") for (int _i = 0; _i < 2; ++_i) \
        __builtin_amdgcn_global_load_lds((const unsigned*)((const char*)(gbase) + (voff)[_i]), (LAS unsigned*)(lds + (bufoff) + ldsw + _i * 8192), 16, 0, 0); } while (0)
#define PG8_LDA(dst, b, h) do { _Pragma("unroll") for (int m = 0; m < 4; ++m) _Pragma("unroll") for (int k = 0; k < 2; ++k) dst[m][k] = *(const LAS bf16x8*)(lds + PG8_SA(b, h) + aoff + m * 2048 + k * 1024); } while (0)
#define PG8_LDB(dst, b, h) do { _Pragma("unroll") for (int n = 0; n < 2; ++n) _Pragma("unroll") for (int k = 0; k < 2; ++k) dst[n][k] = *(const LAS bf16x8*)(lds + PG8_SB(b, h) + boff + n * 2048 + k * 1024); } while (0)
#define PG8_MMA(ai, bj, At, Bt) do { __builtin_amdgcn_s_setprio(1); _Pragma("unroll") for (int m = 0; m < 4; ++m) _Pragma("unroll") for (int n = 0; n < 2; ++n) _Pragma("unroll") for (int k = 0; k < 2; ++k) \
        acc[ai][bj][m][n] = __builtin_amdgcn_mfma_f32_16x16x32_bf16(Bt[n][k], At[m][k], acc[ai][bj][m][n], 0, 0, 0); __builtin_amdgcn_s_setprio(0); } while (0)
#define PG8_WAIT_V(n) asm volatile("s_waitcnt vmcnt(" #n ")" ::: "memory")
#define PG8_WAIT_L(n) asm volatile("s_waitcnt lgkmcnt(" #n ")" ::: "memory")
#define PG8_BAR __builtin_amdgcn_s_barrier()
#define PG8_SCHED __builtin_amdgcn_sched_barrier(0)
    Unit cur, nxt; int ui = 0;
    if (!S.next(0, cur)) return;
    f32x4 acc[2][2][4][2];
#pragma unroll
    for (int a = 0; a < 2; ++a)
#pragma unroll
        for (int b = 0; b < 2; ++b)
#pragma unroll
            for (int m = 0; m < 4; ++m)
#pragma unroll
                for (int n = 0; n < 2; ++n) acc[a][b][m][n] = (f32x4){0.f, 0.f, 0.f, 0.f};
    bf16x8 At[4][2], B0[2][2], B1[2][2];
    unsigned oA0[2], oA1[2], oN0[2], oN1[2];
    PG8_AOFFS(cur, oA0, oA1);
    const char* cB = S.bbase(cur);
    PG8_STAGE(PG8_SB(0, 0), cB, voffB); PG8_STAGE(PG8_SB(0, 1), cB + hstep, voffB); PG8_STAGE(PG8_SA(0, 0), Ab, oA0); PG8_STAGE(PG8_SA(0, 1), Ab, oA1);
    if (wr == 1) PG8_BAR;
    PG8_WAIT_V(2); PG8_BAR;
    PG8_STAGE(PG8_SB(1, 0), cB + kstep, voffB); PG8_STAGE(PG8_SA(1, 0), Ab + kstep, oA0); PG8_STAGE(PG8_SB(1, 1), cB + hstep + kstep, voffB);
    PG8_WAIT_V(6); PG8_BAR;
    for (;;) {
        const bool has_next = S.next(ui + 1, nxt);
        const char* nB = has_next ? S.bbase(nxt) : cB;
        if (has_next) {
            PG8_AOFFS(nxt, oN0, oN1);
        } else {
#pragma unroll
            for (int i = 0; i < 2; ++i) { oN0[i] = oA0[i]; oN1[i] = oA1[i]; }
        }
        for (int t = 0; t < nt; t += 2) {
            const bool last = (t == nt - 2);
            const char* a1 = Ab + (size_t)(t + 1) * kstep;
            const char* a2 = last ? Ab : Ab + (size_t)(t + 2) * kstep; const char* b2 = last ? nB : cB + (size_t)(t + 2) * kstep;
            const char* a3 = a2 + kstep; const char* b3 = b2 + kstep;
            unsigned p0[2], p1[2];
#pragma unroll
            for (int i = 0; i < 2; ++i) { p0[i] = last ? oN0[i] : oA0[i]; p1[i] = last ? oN1[i] : oA1[i]; }
            PG8_LDB(B0, 0, 0); PG8_LDB(B1, 0, 1); PG8_SCHED; PG8_LDA(At, 0, 0); PG8_STAGE(PG8_SA(1, 1), a1, oA1);
            PG8_WAIT_V(8); PG8_WAIT_L(0); PG8_BAR; PG8_MMA(0, 0, At, B0); PG8_MMA(0, 1, At, B1); PG8_BAR; PG8_SCHED;
            PG8_LDA(At, 0, 1); PG8_STAGE(PG8_SB(0, 0), b2, voffB); PG8_STAGE(PG8_SB(0, 1), b2 + hstep, voffB); PG8_STAGE(PG8_SA(0, 0), a2, p0);
            PG8_WAIT_V(8); PG8_WAIT_L(0); PG8_BAR; PG8_MMA(1, 0, At, B0); PG8_MMA(1, 1, At, B1); PG8_BAR; PG8_SCHED;
            PG8_LDB(B0, 1, 0); PG8_LDB(B1, 1, 1); PG8_SCHED; PG8_LDA(At, 1, 0); PG8_STAGE(PG8_SA(0, 1), a2, p1);
            PG8_WAIT_V(8); PG8_WAIT_L(0); PG8_BAR; PG8_MMA(0, 0, At, B0); PG8_MMA(0, 1, At, B1); PG8_BAR; PG8_SCHED;
            PG8_LDA(At, 1, 1); PG8_STAGE(PG8_SB(1, 0), b3, voffB); PG8_STAGE(PG8_SB(1, 1), b3 + hstep, voffB); PG8_STAGE(PG8_SA(1, 0), a3, p0);
            PG8_WAIT_V(8); PG8_WAIT_L(0); PG8_BAR; PG8_MMA(1, 0, At, B0); PG8_MMA(1, 1, At, B1); PG8_BAR; PG8_SCHED;
        }
        if (wr == 0) PG8_BAR;
        E(acc, cur, wr, wc, fr, fq);
        if (!has_next) break;
#pragma unroll
        for (int a = 0; a < 2; ++a)
#pragma unroll
            for (int b = 0; b < 2; ++b)
#pragma unroll
                for (int m = 0; m < 4; ++m)
#pragma unroll
                    for (int n = 0; n < 2; ++n) acc[a][b][m][n] = (f32x4){0.f, 0.f, 0.f, 0.f};
        cur = nxt; cB = nB; ++ui;
#pragma unroll
        for (int i = 0; i < 2; ++i) { oA0[i] = oN0[i]; oA1[i] = oN1[i]; }
        if (wr == 1) PG8_BAR;
    }
    PG8_WAIT_V(0);
    PG8_BAR;
#undef PG8_AOFFS
#undef PG8_SA
#undef PG8_SB
#undef PG8_STAGE
#undef PG8_LDA
#undef PG8_LDB
#undef PG8_MMA
#undef PG8_WAIT_V
#undef PG8_WAIT_L
#undef PG8_BAR
#undef PG8_SCHED
}

__device__ __forceinline__ float row_rs(const float* ssqp, int row, int fq) {
    const f32x4 pp = *(const f32x4*)(ssqp + (size_t)row * 16 + 4 * fq);
    float s = (pp[0] + pp[1]) + (pp[2] + pp[3]);
    s += __shfl_xor(s, 16); s += __shfl_xor(s, 32);
    return rsqrtf(s * (1.0f / 1024.0f) + 1e-6f);
}
struct EpiScaleBf16 {
    static constexpr bool PERM = true;
    bf16* O; int ldc; const float* ssqp; int gelu_tiles;
    __device__ __forceinline__ void operator()(const f32x4 (&acc)[2][2][4][2], const Unit& u, int wr, int wc, int fr, int fq) const {
        const int row0 = u.pm * BM + wr * 64 + fr, col0 = u.pn * BM + wc * 32 + 8 * fq;
        const bool gl = u.pn < gelu_tiles;
#pragma unroll
        for (int ai = 0; ai < 2; ++ai)
#pragma unroll
            for (int m = 0; m < 4; ++m) {
                const int row = row0 + ai * HALF + m * 16;
                const float rs = ssqp ? row_rs(ssqp, row, fq) : 1.0f;
                bf16* rowp = O + (size_t)row * ldc + col0;
#pragma unroll
                for (int bj = 0; bj < 2; ++bj) {
                    f32x4 v0 = acc[ai][bj][m][0] * rs, v1 = acc[ai][bj][m][1] * rs;
                    if (gl) {
#pragma unroll
                        for (int j = 0; j < 4; ++j) { v0[j] = gelu_tanh(v0[j]); v1[j] = gelu_tanh(v1[j]); }
                    }
                    u32x4 w; w.x = cvt_pk_bf16(v0[0], v0[1]); w.y = cvt_pk_bf16(v0[2], v0[3]); w.z = cvt_pk_bf16(v1[0], v1[1]); w.w = cvt_pk_bf16(v1[2], v1[3]);
                    *(u32x4*)(rowp + bj * HALF) = w;
                }
            }
    }
};
struct EpiResidual {
    static constexpr bool PERM = false;
    const float* base; float* h; bf16* hb; float* ssqp;
    __device__ __forceinline__ void operator()(const f32x4 (&acc)[2][2][4][2], const Unit& u, int wr, int wc, int fr, int fq) const {
        const int row0 = u.pm * BM + wr * 64 + fr, col0 = u.pn * BM + wc * 32 + 4 * fq;
#pragma unroll
        for (int ai = 0; ai < 2; ++ai)
#pragma unroll
            for (int m = 0; m < 4; ++m) {
                const int row = row0 + ai * HALF + m * 16; const size_t off = (size_t)row * D + col0; float ss = 0.f;
#pragma unroll
                for (int bj = 0; bj < 2; ++bj)
#pragma unroll
                    for (int n = 0; n < 2; ++n) {
                        f32x4 hv = *(const f32x4*)(base + off + bj * HALF + n * 16); hv = hv + acc[ai][bj][m][n];
                        *(f32x4*)(h + off + bj * HALF + n * 16) = hv;
                        u32x2 w; w.x = cvt_pk_bf16(hv[0], hv[1]); w.y = cvt_pk_bf16(hv[2], hv[3]); *(u32x2*)(hb + off + bj * HALF + n * 16) = w;
                        ss += (hv[0] * hv[0] + hv[1] * hv[1]) + (hv[2] * hv[2] + hv[3] * hv[3]);
                    }
                ss += __shfl_xor(ss, 16); ss += __shfl_xor(ss, 32);
                if (fq == 0) ssqp[(size_t)row * 16 + u.pn * 4 + wc] = ss;
                asm volatile("" ::: "memory");
            }
    }
};
struct EpiMoe1 {
    static constexpr bool PERM = true;
    bf16* hid; const int* list; const float* rsc; const float* gatew;
    __device__ __forceinline__ void operator()(const f32x4 (&acc)[2][2][4][2], const Unit& u, int wr, int wc, int fr, int fq) const {
        const int f0 = u.pn * 128 + wc * 16 + 4 * fq;
#pragma unroll
        for (int ai = 0; ai < 2; ++ai)
#pragma unroll
            for (int m = 0; m < 4; ++m) {
                const int r = ai * HALF + wr * 64 + m * 16 + fr; const bool valid = r < u.rows;
                const int slot = list[u.e * LCAP + u.pm * BM + (valid ? r : u.rows - 1)];
                const float sc = rsc[slot], gw = gatew[slot];
#pragma unroll
                for (int bj = 0; bj < 2; ++bj) {
                    const f32x4 g = acc[ai][bj][m][0] * sc, up = acc[ai][bj][m][1] * sc; f32x4 o;
#pragma unroll
                    for (int j = 0; j < 4; ++j) o[j] = g[j] * __builtin_amdgcn_rcpf(1.0f + __expf(-g[j])) * up[j] * gw;
                    u32x2 w; w.x = cvt_pk_bf16(o[0], o[1]); w.y = cvt_pk_bf16(o[2], o[3]);
                    if (valid) *(u32x2*)(hid + (size_t)slot * 512 + f0 + bj * 64) = w;
                }
            }
    }
};
struct EpiMoe2 {
    static constexpr bool PERM = true;
    bf16* ys; const int* list;
    __device__ __forceinline__ void operator()(const f32x4 (&acc)[2][2][4][2], const Unit& u, int wr, int wc, int fr, int fq) const {
        const int col0 = u.pn * BM + wc * 32 + 8 * fq;
#pragma unroll
        for (int ai = 0; ai < 2; ++ai)
#pragma unroll
            for (int m = 0; m < 4; ++m) {
                const int r = ai * HALF + wr * 64 + m * 16 + fr; const bool valid = r < u.rows;
                const int slot = list[u.e * LCAP + u.pm * BM + (valid ? r : u.rows - 1)];
#pragma unroll
                for (int bj = 0; bj < 2; ++bj) {
                    const f32x4 v0 = acc[ai][bj][m][0], v1 = acc[ai][bj][m][1];
                    u32x4 w; w.x = cvt_pk_bf16(v0[0], v0[1]); w.y = cvt_pk_bf16(v0[2], v0[3]); w.z = cvt_pk_bf16(v1[0], v1[1]); w.w = cvt_pk_bf16(v1[2], v1[3]);
                    if (valid) *(u32x4*)(ys + (size_t)slot * D + col0 + bj * HALF) = w;
                }
            }
    }
};
}


namespace att {
constexpr int SHM_T = 16384;
constexpr int OFF_V = 0, OFF_K = 2 * SHM_T, OFF_WS = 4 * SHM_T, OFF_TAB = 4 * SHM_T + 4096;
#define ATT_KSWZ(row, colB) ((row) * 256 + ((colB) ^ (((row) & 7) << 4)))
__device__ __forceinline__ int crow(int r, int hi) { return (r & 3) + 8 * (r >> 2) + 4 * hi; }
__device__ __forceinline__ int v_st(int k, int c) { const int kk = (k & ~0xC) | ((k & 4) << 1) | ((k & 8) >> 1); return ((kk >> 3) * 4 + (c >> 5)) * 512 + ((kk & 7) * 32 + (c & 31)) * 2; }
__device__ __forceinline__ int v_rd_base(int lane) { return ((lane & 3) << 3) | (((lane >> 2) & 3) << 6) | (((lane >> 4) & 1) << 5) | (((lane >> 5) & 1) << 8); }
constexpr int v_rd_off(int d0, int ks, int half) { return d0 * 512 + ks * 4096 + half * 2048; }
typedef short s16x4 __attribute__((ext_vector_type(4)));
template <int OFF> __device__ __forceinline__ s16x4 tr_read(int vb) {
    s16x4 r; asm volatile("ds_read_b64_tr_b16 %0, %1 offset:%2" : "=&v"(r) : "v"(vb), "i"(OFF) : "memory"); return r;
}
template <int D0> __device__ __forceinline__ void pv_one(f32x16& od, int vb, bf16x8 pa0, bf16x8 pa1, bf16x8 pa2, bf16x8 pa3) {
    const s16x4 l0 = tr_read<v_rd_off(D0, 0, 0)>(vb), h0 = tr_read<v_rd_off(D0, 0, 1)>(vb), l1 = tr_read<v_rd_off(D0, 1, 0)>(vb), h1 = tr_read<v_rd_off(D0, 1, 1)>(vb);
    const s16x4 l2 = tr_read<v_rd_off(D0, 2, 0)>(vb), h2 = tr_read<v_rd_off(D0, 2, 1)>(vb), l3 = tr_read<v_rd_off(D0, 3, 0)>(vb), h3 = tr_read<v_rd_off(D0, 3, 1)>(vb);
    asm volatile("s_waitcnt lgkmcnt(0)" ::: "memory"); __builtin_amdgcn_sched_barrier(0);
#define ATT_PK(L, H) (bf16x8){L[0], L[1], L[2], L[3], H[0], H[1], H[2], H[3]}
    od = __builtin_amdgcn_mfma_f32_32x32x16_bf16(pa0, ATT_PK(l0, h0), od, 0, 0, 0);
    od = __builtin_amdgcn_mfma_f32_32x32x16_bf16(pa1, ATT_PK(l1, h1), od, 0, 0, 0);
    od = __builtin_amdgcn_mfma_f32_32x32x16_bf16(pa2, ATT_PK(l2, h2), od, 0, 0, 0);
    od = __builtin_amdgcn_mfma_f32_32x32x16_bf16(pa3, ATT_PK(l3, h3), od, 0, 0, 0);
#undef ATT_PK
}
template <int DK16, int DV32, bool MASK, int HALFWIN, class P>
__device__ __forceinline__ void attn_unit(LAS unsigned char* lds, const P& c, const int ntiles, const float C) {
    const int tid = otid(), wid = __builtin_amdgcn_readfirstlane(tid >> 6), lane = tid & 63, r32 = lane & 31, hi = lane >> 5;
    LAS unsigned char* V_lds = lds + OFF_V; LAS unsigned char* K_lds = lds + OFF_K;
    LAS float* wsf = (LAS float*)(lds + OFF_WS) + wid * 64; LAS float* li_l = wsf; LAS float* al_l = wsf + 32;
    bf16x8 qr[DK16];
    { const bf16* qp = c.q_ptr(wid, r32) + hi * 8;
#pragma unroll
      for (int d0 = 0; d0 < DK16; ++d0) qr[d0] = *(const bf16x8*)(qp + d0 * 16); }
    float m_reg = c.m0(wid), l_reg = c.l0(wid);
    f32x16 o[DV32];
#pragma unroll
    for (int d = 0; d < DV32; ++d)
#pragma unroll
        for (int r = 0; r < 16; ++r) o[d][r] = 0.f;
    constexpr bool D128 = (DK16 == 8);
    const int sr = D128 ? (tid >> 4) : (tid >> 3), sc = D128 ? (tid & 15) * 8 : (tid & 7) * 8;
    const int vst0 = v_st(sr, sc), vst1 = v_st(32 + sr, sc), kst0 = ATT_KSWZ(sr, sc * 2), kst1 = ATT_KSWZ(32 + sr, sc * 2);
    const int vb0 = (int)(unsigned)(uintptr_t)V_lds + v_rd_base(lane);
    bf16x8 ks0, ks1, vs0, vs1;
#define ATT_LOAD(t) do { const int _j = 64 * (t) + sr; ks0 = *(const bf16x8*)(c.k_ptr(_j) + sc); vs0 = *(const bf16x8*)(c.v_ptr(_j) + sc); \
        if (D128) { ks1 = *(const bf16x8*)(c.k_ptr(_j + 32) + sc); vs1 = *(const bf16x8*)(c.v_ptr(_j + 32) + sc); } } while (0)
#define ATT_WRITE(b) do { *(LAS bf16x8*)(V_lds + (b) * SHM_T + vst0) = vs0; *(LAS bf16x8*)(K_lds + (b) * SHM_T + kst0) = ks0; \
        if (D128) { *(LAS bf16x8*)(V_lds + (b) * SHM_T + vst1) = vs1; *(LAS bf16x8*)(K_lds + (b) * SHM_T + kst1) = ks1; } } while (0)
    ATT_LOAD(0); ATT_WRITE(0); __syncthreads();
    for (int t = 0; t < ntiles; ++t) {
        const int b = t & 1;
        if (t + 1 < ntiles) ATT_LOAD(t + 1);
        if (c.active(wid, t)) {
            f32x16 p0, p1;
#pragma unroll
            for (int r = 0; r < 16; ++r) { p0[r] = 0.f; p1[r] = 0.f; }
            const LAS unsigned char* Ks = K_lds + b * SHM_T;
#pragma unroll
            for (int d0 = 0; d0 < DK16; ++d0) { const int cb = (d0 * 16 + hi * 8) * 2;
                const bf16x8 b0 = *(const LAS bf16x8*)(Ks + ATT_KSWZ(r32, cb)); const bf16x8 b1 = *(const LAS bf16x8*)(Ks + ATT_KSWZ(32 + r32, cb));
                p0 = __builtin_amdgcn_mfma_f32_32x32x16_bf16(b0, qr[d0], p0, 0, 0, 0);
                p1 = __builtin_amdgcn_mfma_f32_32x32x16_bf16(b1, qr[d0], p1, 0, 0, 0); }
            if constexpr (MASK) {
                const int db = c.dbase(wid, r32, t) + 4 * hi, qi = c.qidx(wid, r32); const unsigned L = (unsigned)c.seqlen();
                const LAS float* tb = c.tab(wid) + (db + HALFWIN);
#pragma unroll
                for (int r = 0; r < 16; ++r) { const int dc = (r & 3) + 8 * (r >> 2);
                    { const int d = db + dc; const bool ok = ((unsigned)(d + HALFWIN) <= (unsigned)(2 * HALFWIN)) && ((unsigned)(qi + d) < L); const float tv = tb[dc];
                      p0[r] = ok ? fmaf(p0[r], C, tv) : -__builtin_inff(); }
                    { const int d = db + dc + 32; const bool ok = ((unsigned)(d + HALFWIN) <= (unsigned)(2 * HALFWIN)) && ((unsigned)(qi + d) < L); const float tv = tb[dc + 32];
                      p1[r] = ok ? fmaf(p1[r], C, tv) : -__builtin_inff(); } }
            } else {
#pragma unroll
                for (int r = 0; r < 16; ++r) { p0[r] *= C; p1[r] *= C; }
            }
            float pmax = p0[0];
#pragma unroll
            for (int r = 1; r < 16; ++r) pmax = fmaxf(pmax, p0[r]);
#pragma unroll
            for (int r = 0; r < 16; ++r) pmax = fmaxf(pmax, p1[r]);
            { auto rr = __builtin_amdgcn_permlane32_swap(__float_as_uint(pmax), __float_as_uint(pmax), false, false);
              pmax = fmaxf(__uint_as_float(rr[0]), __uint_as_float(rr[1])); }
            const float mn = fmaxf(m_reg, pmax), alpha = __builtin_amdgcn_exp2f(m_reg - mn); m_reg = mn;
            float ps = 0.f;
#pragma unroll
            for (int r = 0; r < 16; ++r) { p0[r] = __builtin_amdgcn_exp2f(p0[r] - mn); p1[r] = __builtin_amdgcn_exp2f(p1[r] - mn); ps += p0[r] + p1[r]; }
            { auto rr = __builtin_amdgcn_permlane32_swap(__float_as_uint(ps), __float_as_uint(ps), false, false);
              ps = __uint_as_float(rr[0]) + __uint_as_float(rr[1]); }
            l_reg = l_reg * alpha + ps;
            bf16x8 pa0, pa1, pa2, pa3;
#define ATT_PK4(Pv, BASE, OUT) do { const unsigned a0 = cvt_pk_bf16(Pv[BASE + 0], Pv[BASE + 1]), a1 = cvt_pk_bf16(Pv[BASE + 2], Pv[BASE + 3]); \
        const unsigned b0_ = cvt_pk_bf16(Pv[BASE + 4], Pv[BASE + 5]), b1_ = cvt_pk_bf16(Pv[BASE + 6], Pv[BASE + 7]); \
        auto r0 = __builtin_amdgcn_permlane32_swap(a0, b0_, false, false); auto r1 = __builtin_amdgcn_permlane32_swap(a1, b1_, false, false); \
        u32x4 w = {r0[0], r1[0], r0[1], r1[1]}; OUT = *reinterpret_cast<bf16x8*>(&w); } while (0)
            ATT_PK4(p0, 0, pa0); ATT_PK4(p0, 8, pa1); ATT_PK4(p1, 0, pa2); ATT_PK4(p1, 8, pa3);
#undef ATT_PK4
            if (__any(alpha < 1.f)) { if (hi == 0) al_l[r32] = alpha; asm volatile("s_waitcnt lgkmcnt(0)" ::: "memory");
#pragma unroll
                for (int r = 0; r < 16; ++r) { const float a = al_l[crow(r, hi)];
#pragma unroll
                    for (int d = 0; d < DV32; ++d) o[d][r] *= a; } }
            const int vb = vb0 + b * SHM_T;
            pv_one<0>(o[0], vb, pa0, pa1, pa2, pa3); pv_one<1>(o[1], vb, pa0, pa1, pa2, pa3);
            if constexpr (DV32 == 4) { pv_one<2>(o[2], vb, pa0, pa1, pa2, pa3); pv_one<3>(o[3], vb, pa0, pa1, pa2, pa3); }
        }
        if (t + 1 < ntiles) ATT_WRITE((t + 1) & 1);
        __syncthreads();
    }
#undef ATT_LOAD
#undef ATT_WRITE
    if (hi == 0) li_l[r32] = l_reg; asm volatile("s_waitcnt lgkmcnt(0)" ::: "memory");
    if (hi == 0) c.lse_store(wid, r32, (m_reg + __builtin_amdgcn_logf(l_reg)) * 0.6931471805599453f);
#pragma unroll
    for (int r = 0; r < 16; ++r) { const int orow = crow(r, hi); const float rl = __builtin_amdgcn_rcpf(li_l[orow]); bf16* op = c.out_ptr(wid, orow) + r32;
#pragma unroll
        for (int d = 0; d < DV32; ++d) op[d * 32] = f2bf(o[d][r] * rl); }
    asm volatile("s_waitcnt lgkmcnt(0)" ::: "memory");
}
#undef ATT_KSWZ

struct XattP {
    const bf16* qx; const bf16* kv; bf16* ox; int q0, h;
    __device__ __forceinline__ const bf16* q_ptr(int w, int r32) const { return qx + (size_t)(q0 + 32 * w + r32) * 512 + h * 128; }
    __device__ __forceinline__ const bf16* k_ptr(int j) const { return kv + (size_t)j * 1024 + h * 128; }
    __device__ __forceinline__ const bf16* v_ptr(int j) const { return kv + (size_t)j * 1024 + 512 + h * 128; }
    __device__ __forceinline__ bool active(int, int) const { return true; }
    __device__ __forceinline__ int dbase(int, int, int) const { return 0; }
    __device__ __forceinline__ int qidx(int, int) const { return 0; }
    __device__ __forceinline__ int seqlen() const { return 0; }
    __device__ __forceinline__ float m0(int) const { return -1e30f; }
    __device__ __forceinline__ float l0(int) const { return 0.f; }
    __device__ __forceinline__ const LAS float* tab(int) const { return nullptr; }
    __device__ __forceinline__ bf16* out_ptr(int w, int row) const { return ox + (size_t)(q0 + 32 * w + row) * 512 + h * 128; }
    __device__ __forceinline__ void lse_store(int, int, float) const {}
};
struct DattP {
    bf16* z; float* lse; const LAS float* tb; int g, h, dil, r, i0, L;
    __device__ __forceinline__ size_t rowoff(int idx) const { return (size_t)(idx * dil + r) * ODD_IN + g * 3072 + h * 128; }
    __device__ __forceinline__ const bf16* q_ptr(int w, int r32) const { return z + rowoff(i0 + 32 * w + r32); }
    __device__ __forceinline__ int kidx(int j) const { int jj = i0 - 64 + j; jj = jj < 0 ? 0 : jj; return jj > L - 1 ? L - 1 : jj; }
    __device__ __forceinline__ const bf16* k_ptr(int j) const { return z + rowoff(kidx(j)) + 1024; }
    __device__ __forceinline__ const bf16* v_ptr(int j) const { return z + rowoff(kidx(j)) + 2048; }
    __device__ __forceinline__ bool active(int w, int t) const { return t >= (w >> 1) && t <= (w >> 1) + 2; }
    __device__ __forceinline__ int dbase(int w, int r32, int t) const { return 64 * t - 64 - 32 * w - r32; }
    __device__ __forceinline__ int qidx(int w, int r32) const { return i0 + 32 * w + r32; }
    __device__ __forceinline__ int seqlen() const { return L; }
    __device__ __forceinline__ float m0(int) const { return -1e30f; }
    __device__ __forceinline__ float l0(int) const { return 0.f; }
    __device__ __forceinline__ const LAS float* tab(int) const { return tb; }
    __device__ __forceinline__ bf16* out_ptr(int w, int row) const { return z + rowoff(i0 + 32 * w + row); }
    __device__ __forceinline__ void lse_store(int w, int row, float v) const { lse[((size_t)g * S + (size_t)(i0 + 32 * w + row) * dil + r) * 8 + h] = v; }
};
struct WattP {
    const bf16* z; bf16* y; const LAS float* tb; const float* sink; int kv, q0;
    __device__ __forceinline__ const bf16* q_ptr(int w, int r32) const { return z + (size_t)(q0 + 32 * (w >> 2) + r32) * EVEN_IN + 1024 + (kv * 4 + (w & 3)) * 64; }
    __device__ __forceinline__ int kpos(int j) const { int jj = q0 - 128 + j; jj = jj < 0 ? 0 : jj; return jj > S - 1 ? S - 1 : jj; }
    __device__ __forceinline__ const bf16* k_ptr(int j) const { return z + (size_t)kpos(j) * EVEN_IN + 1536 + kv * 64; }
    __device__ __forceinline__ const bf16* v_ptr(int j) const { return z + (size_t)kpos(j) * EVEN_IN + 1664 + kv * 64; }
    __device__ __forceinline__ bool active(int, int) const { return true; }
    __device__ __forceinline__ int dbase(int w, int r32, int t) const { return 64 * t - 128 - 32 * (w >> 2) - r32; }
    __device__ __forceinline__ int qidx(int w, int r32) const { return q0 + 32 * (w >> 2) + r32; }
    __device__ __forceinline__ int seqlen() const { return S; }
    __device__ __forceinline__ float m0(int w) const { return sink[kv * 4 + (w & 3)] * 1.4426950408889634f; }
    __device__ __forceinline__ float l0(int) const { return 1.f; }
    __device__ __forceinline__ const LAS float* tab(int w) const { return tb + (w & 3) * 257; }
    __device__ __forceinline__ bf16* out_ptr(int w, int row) const { return y + (size_t)(q0 + 32 * (w >> 2) + row) * D + 512 + (kv * 4 + (w & 3)) * 64; }
    __device__ __forceinline__ void lse_store(int, int, float) const {}
};
}

template <class RM>
__device__ __forceinline__ void cvt_item(const float* W, int N, int K, const float* g, bf16* WT, RM rowmap, LAS float* scr, int kb, int nb, int lane) {
    const int k0 = 64 * kb, n0 = 32 * nb;
    float v[32];
#pragma unroll
    for (int i = 0; i < 32; ++i) { const int kk = 2 * i + (lane >> 5); v[i] = W[(size_t)(k0 + kk) * N + n0 + (lane & 31)]; }
    if (g) {
#pragma unroll
        for (int i = 0; i < 32; ++i) v[i] *= g[k0 + 2 * i + (lane >> 5)];
    }
#pragma unroll
    for (int i = 0; i < 32; ++i) { const int kk = 2 * i + (lane >> 5); scr[kk * 33 + (lane & 31)] = v[i]; }
    asm volatile("s_waitcnt lgkmcnt(0)" ::: "memory");
    const int c = lane & 7;
#pragma unroll
    for (int j = 0; j < 4; ++j) { const int n = (lane >> 3) + 8 * j; const LAS float* s = scr + (8 * c) * 33 + n;
        u32x4 o; o.x = cvt_pk_bf16(s[0 * 33], s[1 * 33]); o.y = cvt_pk_bf16(s[2 * 33], s[3 * 33]); o.z = cvt_pk_bf16(s[4 * 33], s[5 * 33]); o.w = cvt_pk_bf16(s[6 * 33], s[7 * 33]);
        *(u32x4*)(WT + (size_t)rowmap(n0 + n) * K + k0 + 8 * c) = o; }
    asm volatile("s_waitcnt lgkmcnt(0)" ::: "memory");
}
struct CvtCtx { int gw, NGW, base, lane; LAS float* scr; };
template <class RM>
__device__ __forceinline__ void cvt_matrix(CvtCtx& c, const float* W, int K, int N, const float* g, bf16* WT, RM rowmap) {
    const int nblk = N / 32, nitems = (K / 64) * nblk;
    int j0 = (c.gw - c.base) % c.NGW; if (j0 < 0) j0 += c.NGW;
    for (int j = j0; j < nitems; j += c.NGW) cvt_item(W, N, K, g, WT, rowmap, c.scr, j / nblk, j % nblk, c.lane);
    c.base = (c.base + nitems) % c.NGW;
}

__device__ __forceinline__ void rms_row_bf16(const float4 (&v)[4], float rs, const float* g, bf16* dst, int lane) {
#pragma unroll
    for (int j = 0; j < 4; ++j) { const float4 gg = g ? ((const float4*)g)[lane + 64 * j] : make_float4(1.f, 1.f, 1.f, 1.f);
        u32x2 w; w.x = cvt_pk_bf16(v[j].x * rs * gg.x, v[j].y * rs * gg.y); w.y = cvt_pk_bf16(v[j].z * rs * gg.z, v[j].w * rs * gg.w); ((u32x2*)dst)[lane + 64 * j] = w; }
}

enum Phase { PH_INIT = 0, PH_EXPCVT, PH_GEMM1, PH_SGU, PH_WATT, PH_DATT, PH_COMB, PH_GEMM2, PH_GEMM3, PH_XATT, PH_GEMM4, PH_ROUTE, PH_MOE1, PH_MOE2, PH_FIN };

template <int PH>
__device__ __forceinline__ void run_phase(const Params& p, int layer, LAS unsigned char* lds) {
    unsigned char* ws = p.ws;
    asm volatile("" : "+s"(ws), "+s"(layer));
    float* h = (float*)(ws + WS_H); bf16* hb = (bf16*)(ws + WS_HB); bf16* y = (bf16*)(ws + WS_Y); bf16* z = (bf16*)(ws + WS_Z);
    bf16* wnx = (bf16*)(ws + WS_WNX); bf16* wex = (bf16*)(ws + WS_WEX);
    float* bte = (float*)(ws + WS_MISC + MISC_BTE); float* bto = (float*)(ws + WS_MISC + MISC_BTO);
    bf16* memn = (bf16*)(ws + WS_MISC + MISC_MEMN); bf16* kvm = (bf16*)(ws + WS_MISC + MISC_KV);
    int* lists = (int*)(ws + WS_MISC + MISC_LIST); float* gatew = (float*)(ws + WS_MISC + MISC_GW); float* rsc = (float*)(ws + WS_MISC + MISC_RSC);
    float* ssqp = (float*)(ws + WS_MISC + MISC_SSQ);
    bf16* qx = (bf16*)(ws + WS_Z + Z_QX); bf16* ox = (bf16*)(ws + WS_Z + Z_OX); bf16* hid = (bf16*)(ws + WS_Z + Z_HID); bf16* ys = (bf16*)(ws + WS_Z + Z_YS); float* vn = (float*)(ws + WS_Z + Z_VN);
    unsigned* ctl = (unsigned*)(ws + WS_CTL);
    const int tid = otid(), lane = tid & 63, wv = tid >> 6; const int bid = obid();
    const int gtid = bid * NT + tid, GT = gridDim.x * NT;
    const int gw = bid * (NT / 64) + wv, NGW = gridDim.x * (NT / 64);
    const int il = layer >> 1;
    const bool even = (layer & 1) == 0;
    const int G = gridDim.x;

    if constexpr (PH == PH_INIT) {
        for (int i = gtid; i < 8 * 257; i += GT) { const int hh = i / 257, rel = i % 257 - 128; bte[i] = p.rel_table[t5_bucket(rel) * 8 + hh]; }
        for (int i = gtid; i < 3 * 8 * 129; i += GT) { const int g = i / (8 * 129), hh = (i / 129) % 8, j = i % 129 - 64; const int dil = g == 0 ? 1 : (g == 1 ? 4 : 16); bto[i] = p.rel_table[t5_bucket(j * dil) * 8 + hh]; }
        { bf16* sgwd = (bf16*)(ws + WS_MISC + MISC_SGW); for (int i = gtid; i < 2 * 4 * 128 * 128; i += GT) sgwd[i] = f2bf(p.sgu_w[i]); }
        for (int r = gw; r < S; r += NGW) {
            const float4* s4 = (const float4*)(p.x + (size_t)r * D); float4 v[4]; float ss = 0.f;
#pragma unroll
            for (int j = 0; j < 4; ++j) { v[j] = s4[lane + 64 * j]; ss += v[j].x * v[j].x + v[j].y * v[j].y + v[j].z * v[j].z + v[j].w * v[j].w; }
            ss = wave_sum(ss);
            rms_row_bf16(v, 1.0f, nullptr, hb + (size_t)r * D, lane);
            if (lane < 16) ssqp[(size_t)r * 16 + lane] = lane == 0 ? ss : 0.f;
        }
        for (int r = gw; r < MEM; r += NGW) {
            const float4* s4 = (const float4*)(p.mem + (size_t)r * D); float4 v[4]; float ss = 0.f;
#pragma unroll
            for (int j = 0; j < 4; ++j) { v[j] = s4[lane + 64 * j]; ss += v[j].x * v[j].x + v[j].y * v[j].y + v[j].z * v[j].z + v[j].w * v[j].w; }
            const float rs = rsqrtf(wave_sum(ss) * (1.0f / D) + 1e-6f);
            for (int l = 0; l < DEPTH; ++l) rms_row_bf16(v, rs, p.ln_mem + l * D, memn + ((size_t)l * MEM + r) * D, lane);
        }
        CvtCtx c{gw, NGW, 0, lane, (LAS float*)(lds + wv * 16384)};
        auto idm = [](int n) { return n; };
        for (int i = 0; i < 2; ++i) {
            cvt_matrix(c, p.even_w_in + (size_t)i * D * EVEN_IN, D, EVEN_IN, p.ln_mix + (2 * i) * D, wnx + WO_W1E + i * W1E_SZ, idm);
            cvt_matrix(c, p.even_w_out + (size_t)i * D * D, D, D, nullptr, wnx + WO_W2E + i * W2_SZ, idm);
            cvt_matrix(c, p.odd_w_in + (size_t)i * D * ODD_IN, D, ODD_IN, p.ln_mix + (2 * i + 1) * D, wnx + WO_W1O + i * W1O_SZ, idm);
            cvt_matrix(c, p.odd_w_out + (size_t)i * D * D, D, D, nullptr, wnx + WO_W2O + i * W2_SZ, idm);
        }
        for (int l = 0; l < DEPTH; ++l) {
            cvt_matrix(c, p.xq_w + (size_t)l * D * 512, D, 512, p.ln_cross + l * D, wnx + WO_WQ + l * WQ_SZ, idm);
            cvt_matrix(c, p.xkv_w + (size_t)l * D * 1024, D, 1024, nullptr, wnx + WO_WKV + l * WKV_SZ, idm);
            cvt_matrix(c, p.xo_w + (size_t)l * 512 * D, 512, D, nullptr, wnx + WO_WO + l * WO_SZ, idm);
        }
    }
    if constexpr (PH == PH_EXPCVT) {
        CvtCtx c{gw, NGW, 0, lane, (LAS float*)(lds + wv * 16384)};
        const float* gf = p.ln_ffn + layer * D;
        for (int e = 0; e < 16; ++e) {
            cvt_matrix(c, p.ewg + ((size_t)layer * 16 + e) * D * 512, D, 512, gf, wex + e * WGU_SZ, [](int n) { return 8 * (n >> 2) + (n & 3); });
            cvt_matrix(c, p.ewu + ((size_t)layer * 16 + e) * D * 512, D, 512, gf, wex + e * WGU_SZ, [](int n) { return 8 * (n >> 2) + 4 + (n & 3); });
            cvt_matrix(c, p.ewd + ((size_t)layer * 16 + e) * 512 * D, 512, D, nullptr, wex + WEX_WD + e * WD_SZ, [](int n) { return n; });
        }
    }
    if constexpr (PH == PH_GEMM1) {
        const int N = even ? EVEN_IN : ODD_IN;
        const bf16* W = even ? wnx + WO_W1E + il * W1E_SZ : wnx + WO_W1O + il * W1O_SZ;
        pg8::DenseSched Sd; Sd.init(S, N, D, W, G, bid);
        pg8::EpiScaleBf16 E{z, N, ssqp, even ? 4 : 0};
        pg8::gemm_phase(lds, hb, D, Sd, E);
        if (layer == 0 && bid >= G - 16) {
            const int uidx = bid - (G - 16), l = uidx >> 2;
            pg8::DenseSched Sk; Sk.init(MEM, 1024, D, wnx + WO_WKV + l * WKV_SZ, 4, uidx & 3);
            pg8::EpiScaleBf16 Ek{kvm + (size_t)l * MEM * 1024, 1024, nullptr, 0};
            pg8::gemm_phase(lds, memn + (size_t)l * MEM * D, D, Sk, Ek);
        }
    }
    if constexpr (PH == PH_SGU) {
        const bf16* sgw = (const bf16*)(ws + WS_MISC + MISC_SGW) + (size_t)il * 4 * 128 * 128;
        const float* lg = p.sgu_ln_g + il * 512; const float* lb = p.sgu_ln_b + il * 512; const float* bs = p.sgu_b + il * 512;
        LAS unsigned char* vnt = lds + 77824;
        LAS float* st = (LAS float*)(lds + 77824 + 34816);
        const int wid = __builtin_amdgcn_readfirstlane(tid >> 6), r32 = lane & 31, hi = lane >> 5;
        for (int u = bid; u < 512; u += G) {
            const int g = u & 3, t0 = (u >> 2) * 128;
            {
                const int q = tid >> 2, part = tid & 3; const bf16* vp = z + (size_t)(t0 + q) * EVEN_IN + 512 + part * 128; float s = 0.f, s2 = 0.f;
#pragma unroll
                for (int i = 0; i < 16; ++i) { const u32x4 w = *(const u32x4*)(vp + 8 * i);
#pragma unroll
                    for (int k = 0; k < 4; ++k) { const float a = __uint_as_float(w[k] << 16), b = __uint_as_float(w[k] & 0xffff0000u); s += a + b; s2 += a * a + b * b; } }
                s += __shfl_xor(s, 1); s += __shfl_xor(s, 2); s2 += __shfl_xor(s2, 1); s2 += __shfl_xor(s2, 2);
                const float mu = s * (1.f / 512.f), var = s2 * (1.f / 512.f) - mu * mu;
                if (part == 0) { st[2 * q] = mu; st[2 * q + 1] = rsqrtf(fmaxf(var, 0.f) + 1e-6f); }
            }
            __syncthreads();
#pragma unroll
            for (int it = 0; it < 4; ++it) {
                const int item = tid + NT * it, q = item & 127, cc = item >> 7;
                const u32x4 w = *(const u32x4*)(z + (size_t)(t0 + q) * EVEN_IN + 512 + g * 128 + 8 * cc); const float mu = st[2 * q], rstd = st[2 * q + 1];
#pragma unroll
                for (int k = 0; k < 8; ++k) { const int c = 8 * cc + k; const float v = (k & 1) ? __uint_as_float(w[k >> 1] & 0xffff0000u) : __uint_as_float(w[k >> 1] << 16);
                    *(LAS bf16*)(vnt + c * 272 + q * 2) = f2bf((v - mu) * rstd * lg[g * 128 + c] + lb[g * 128 + c]); }
            }
            __syncthreads();
            const int pb = wid >> 1, cb0 = (wid & 1) * 2;
            bf16x8 af[8];
#pragma unroll
            for (int ks = 0; ks < 8; ++ks) af[ks] = *(const bf16x8*)(sgw + (size_t)(g * 128 + 32 * pb + r32) * 128 + 16 * ks + 8 * hi);
            f32x16 acc0, acc1;
#pragma unroll
            for (int r = 0; r < 16; ++r) { acc0[r] = 0.f; acc1[r] = 0.f; }
#pragma unroll
            for (int ks = 0; ks < 8; ++ks) {
                const bf16x8 b0 = *(const LAS bf16x8*)(vnt + (32 * cb0 + r32) * 272 + (16 * ks + 8 * hi) * 2);
                const bf16x8 b1 = *(const LAS bf16x8*)(vnt + (32 * (cb0 + 1) + r32) * 272 + (16 * ks + 8 * hi) * 2);
                acc0 = __builtin_amdgcn_mfma_f32_32x32x16_bf16(af[ks], b0, acc0, 0, 0, 0);
                acc1 = __builtin_amdgcn_mfma_f32_32x32x16_bf16(af[ks], b1, acc1, 0, 0, 0);
            }
#pragma unroll
            for (int r = 0; r < 16; ++r) {
                const int prow = 32 * pb + att::crow(r, hi), tok = t0 + prow; const float bias = bs[g * 128 + prow];
                const int col = g * 128 + 32 * cb0 + r32;
                y[(size_t)tok * D + col] = f2bf(bf2f(z[(size_t)tok * EVEN_IN + col]) * (acc0[r] + bias));
                y[(size_t)tok * D + col + 32] = f2bf(bf2f(z[(size_t)tok * EVEN_IN + col + 32]) * (acc1[r] + bias));
            }
            __syncthreads();
        }
    }
    if constexpr (PH == PH_WATT) {
        LAS float* tb = (LAS float*)(lds + att::OFF_TAB);
        for (int u = bid; u < (S / 64) * 2; u += G) {
            const int kv = u & 1, blk = u >> 1;
            for (int i = tid; i < 4 * 257; i += NT) tb[i] = bte[(kv * 4 + i / 257) * 257 + i % 257] * 1.4426950408889634f;
            att::WattP P{z, y, tb, p.attn_sink + il * 8, kv, blk * 64};
            att::attn_unit<4, 2, true, 128>(lds, P, 5, 0.125f * 1.4426950408889634f);
        }
    }
    if constexpr (PH == PH_DATT) {
        float* lse = (float*)(ws + WS_MISC + MISC_LSE);
        LAS float* tb = (LAS float*)(lds + att::OFF_TAB);
        for (int u = bid; u < 3 * 512; u += G) {
            const int g = u >> 9, uu = u & 511, hh = uu & 7, rest = uu >> 3;
            const int dil = g == 0 ? 1 : (g == 1 ? 4 : 16), r = rest % dil, blk = rest / dil;
            if (tid < 129) tb[tid] = bto[(g * 8 + hh) * 129 + tid] * 1.4426950408889634f;
            att::DattP P{z, lse, tb, g, hh, dil, r, blk * 256, S / dil};
            att::attn_unit<8, 4, true, 64>(lds, P, 6, 0.08838834764831845f * 1.4426950408889634f);
        }
    }
    if constexpr (PH == PH_COMB) {
        const float* lse = (const float*)(ws + WS_MISC + MISC_LSE);
        for (int i = gtid; i < S * 128; i += GT) {
            const int pos = i >> 7, ch = i & 127, hh = ch >> 4;
            const float l0 = lse[((size_t)0 * S + pos) * 8 + hh], l1 = lse[((size_t)1 * S + pos) * 8 + hh], l2 = lse[((size_t)2 * S + pos) * 8 + hh];
            const float mx = fmaxf(l0, fmaxf(l1, l2)); float w0 = __expf(l0 - mx), w1 = __expf(l1 - mx), w2 = __expf(l2 - mx); const float inv = 1.0f / (w0 + w1 + w2); w0 *= inv; w1 *= inv; w2 *= inv;
            const bf16* zr = z + (size_t)pos * ODD_IN + ch * 8;
            const u32x4 a = *(const u32x4*)zr, b = *(const u32x4*)(zr + 3072), c = *(const u32x4*)(zr + 6144); u32x4 o;
#pragma unroll
            for (int k = 0; k < 4; ++k) {
                const float lo = w0 * __uint_as_float(a[k] << 16) + w1 * __uint_as_float(b[k] << 16) + w2 * __uint_as_float(c[k] << 16);
                const float hi2 = w0 * __uint_as_float(a[k] & 0xffff0000u) + w1 * __uint_as_float(b[k] & 0xffff0000u) + w2 * __uint_as_float(c[k] & 0xffff0000u);
                o[k] = cvt_pk_bf16(lo, hi2); }
            *(u32x4*)(y + (size_t)pos * D + ch * 8) = o;
        }
    }
    if constexpr (PH == PH_GEMM2) {
        const bf16* W = even ? wnx + WO_W2E + il * W2_SZ : wnx + WO_W2O + il * W2_SZ;
        pg8::DenseSched Sd; Sd.init(S, D, D, W, G, bid);
        pg8::EpiResidual E{layer == 0 ? p.x : h, h, hb, ssqp};
        pg8::gemm_phase(lds, y, D, Sd, E);
    }
    if constexpr (PH == PH_GEMM3) {
        pg8::DenseSched Sd; Sd.init(S, 512, D, wnx + WO_WQ + layer * WQ_SZ, G, bid);
        pg8::EpiScaleBf16 E{qx, 512, ssqp, 0};
        pg8::gemm_phase(lds, hb, D, Sd, E);
    }
    if constexpr (PH == PH_XATT) {
        const bf16* kvl = kvm + (size_t)layer * MEM * 1024;
        for (int u = bid; u < (S / 256) * 4; u += G) {
            att::XattP P{qx, kvl, ox, (u >> 2) * 256, u & 3};
            att::attn_unit<8, 4, false, 64>(lds, P, 4, 0.08838834764831845f * 1.4426950408889634f);
        }
    }
    if constexpr (PH == PH_GEMM4) {
        pg8::DenseSched Sd; Sd.init(S, D, 512, wnx + WO_WO + layer * WO_SZ, G, bid);
        pg8::EpiResidual E{h, h, hb, ssqp};
        pg8::gemm_phase(lds, ox, 512, Sd, E);
    }
    if constexpr (PH == PH_ROUTE) {
        const float* wg = p.rgw + (size_t)layer * D * 4; const float* we = p.rew + (size_t)layer * D * 16;
        const float* bg = p.rgb + layer * 4; const float* be = p.reb + layer * 16; const float* gf = p.ln_ffn + layer * D;
        for (int t = gw; t < S; t += NGW) {
            float ssq = lane < 16 ? ssqp[(size_t)t * 16 + lane] : 0.f; ssq = wave_sum(ssq);
            const float rs = rsqrtf(ssq * (1.0f / D) + 1e-6f);
            float lg[4], le[16];
#pragma unroll
            for (int c = 0; c < 4; ++c) lg[c] = 0.f;
#pragma unroll
            for (int c = 0; c < 16; ++c) le[c] = 0.f;
            for (int k = lane; k < D; k += 64) {
                const float xv = h[(size_t)t * D + k] * rs * gf[k];
                const float4 g4 = *(const float4*)(wg + (size_t)k * 4);
                lg[0] += xv * g4.x; lg[1] += xv * g4.y; lg[2] += xv * g4.z; lg[3] += xv * g4.w;
#pragma unroll
                for (int c4 = 0; c4 < 4; ++c4) { const float4 e4 = *(const float4*)(we + (size_t)k * 16 + c4 * 4); le[c4 * 4 + 0] += xv * e4.x; le[c4 * 4 + 1] += xv * e4.y; le[c4 * 4 + 2] += xv * e4.z; le[c4 * 4 + 3] += xv * e4.w; }
            }
#pragma unroll
            for (int c = 0; c < 4; ++c) lg[c] = wave_sum(lg[c]) + bg[c];
#pragma unroll
            for (int c = 0; c < 16; ++c) le[c] = wave_sum(le[c]) + be[c];
            if (lane == 0) {
                int grp = 0; float gm = lg[0];
#pragma unroll
                for (int c = 1; c < 4; ++c) if (lg[c] > gm) { gm = lg[c]; grp = c; }
                float gs = 0.f;
#pragma unroll
                for (int c = 0; c < 4; ++c) gs += __expf(lg[c] - gm);
                const float ggate = 1.0f / gs;
                float es[4];
#pragma unroll
                for (int e = 0; e < 4; ++e) es[e] = grp == 0 ? le[e] : (grp == 1 ? le[4 + e] : (grp == 2 ? le[8 + e] : le[12 + e]));
                int i0 = 0; float v0 = es[0];
#pragma unroll
                for (int e = 1; e < 4; ++e) if (es[e] > v0) { v0 = es[e]; i0 = e; }
                int i1 = -1; float v1 = -3.0e38f;
#pragma unroll
                for (int e = 0; e < 4; ++e) if (e != i0 && es[e] > v1) { v1 = es[e]; i1 = e; }
                const float ex = __expf(v1 - v0); const float w0 = 1.0f / (1.0f + ex), w1 = ex / (1.0f + ex);
                const int E0 = grp * 4 + i0, E1 = grp * 4 + i1;
                const unsigned p0 = atomicAdd(&ctl[CW_CNT + (layer * 16 + E0) * 64], 1u);
                const unsigned p1 = atomicAdd(&ctl[CW_CNT + (layer * 16 + E1) * 64], 1u);
                lists[E0 * LCAP + p0] = 2 * t; lists[E1 * LCAP + p1] = 2 * t + 1;
                gatew[2 * t] = ggate * w0; gatew[2 * t + 1] = ggate * w1;
                rsc[2 * t] = rs; rsc[2 * t + 1] = rs;
            }
        }
    }
    if constexpr (PH == PH_MOE1 || PH == PH_MOE2) {
        LAS int* moe = (LAS int*)(lds + LDS_MOE);
        if (tid == 0) { int acc = 0; for (int e = 0; e < 16; ++e) { const int c = (int)ctl[CW_CNT + (layer * 16 + e) * 64]; moe[e] = acc; moe[17 + e] = c; acc += (c + 255) >> 8; } moe[16] = acc; }
        __syncthreads();
        if constexpr (PH == PH_MOE1) {
            pg8::MoeSched<true> Sm{4, G, bid, D, wex, WGU_SZ, lists, moe};
            pg8::EpiMoe1 E{hid, lists, rsc, gatew};
            pg8::gemm_phase(lds, hb, D, Sm, E);
        } else {
            pg8::MoeSched<false> Sm{4, G, bid, 512, wex + WEX_WD, WD_SZ, lists, moe};
            pg8::EpiMoe2 E{ys, lists};
            pg8::gemm_phase(lds, hid, 512, Sm, E);
        }
        __syncthreads();
    }
    if constexpr (PH == PH_FIN) {
        for (int r = gw; r < S; r += NGW) {
            const float4* s4 = (const float4*)(h + (size_t)r * D); float4 v[4]; float ss = 0.f;
            const u32x2* y0 = (const u32x2*)(ys + (size_t)(2 * r) * D); const u32x2* y1 = (const u32x2*)(ys + (size_t)(2 * r + 1) * D);
#pragma unroll
            for (int j = 0; j < 4; ++j) {
                v[j] = s4[lane + 64 * j]; const u32x2 a = y0[lane + 64 * j], b = y1[lane + 64 * j];
                v[j].x += __uint_as_float(a.x << 16) + __uint_as_float(b.x << 16); v[j].y += __uint_as_float(a.x & 0xffff0000u) + __uint_as_float(b.x & 0xffff0000u);
                v[j].z += __uint_as_float(a.y << 16) + __uint_as_float(b.y << 16); v[j].w += __uint_as_float(a.y & 0xffff0000u) + __uint_as_float(b.y & 0xffff0000u);
                ss += v[j].x * v[j].x + v[j].y * v[j].y + v[j].z * v[j].z + v[j].w * v[j].w;
            }
            ss = wave_sum(ss);
            if (layer == DEPTH - 1) {
                const float rs = rsqrtf(ss * (1.0f / D) + 1e-6f); float4* o4 = (float4*)(p.out + (size_t)r * D);
#pragma unroll
                for (int j = 0; j < 4; ++j) { const float4 gg = ((const float4*)p.ln_final)[lane + 64 * j]; float4 o; o.x = v[j].x * rs * gg.x; o.y = v[j].y * rs * gg.y; o.z = v[j].z * rs * gg.z; o.w = v[j].w * rs * gg.w; o4[lane + 64 * j] = o; }
            } else {
                float4* d4 = (float4*)(h + (size_t)r * D);
#pragma unroll
                for (int j = 0; j < 4; ++j) d4[lane + 64 * j] = v[j];
                rms_row_bf16(v, 1.0f, nullptr, hb + (size_t)r * D, lane);
                if (lane < 16) ssqp[(size_t)r * 16 + lane] = lane == 0 ? ss : 0.f;
            }
        }
    }
}

__global__ void __launch_bounds__(NT, 2) k_mega(Params p) {
    extern __shared__ __attribute__((aligned(16))) unsigned char lds_[];
    LAS unsigned char* lds = (LAS unsigned char*)lds_;
    if (threadIdx.x < 4) ((LAS unsigned*)(lds + LDS_BARW))[threadIdx.x] = 0u;
    __syncthreads();
    XcdBarrier bar = xcd_barrier_post((unsigned*)(p.ws + WS_CTL) + CW_BAR, (volatile LAS unsigned*)(lds + LDS_BARW));
#define PHB(PH, l) do { run_phase<PH>(p, l, lds); xcd_barrier(bar); } while (0)
    PHB(PH_INIT, 0);
    for (int l = 0; l < DEPTH; ++l) {
        PHB(PH_GEMM1, l);
        if ((l & 1) == 0) { run_phase<PH_SGU>(p, l, lds); PHB(PH_WATT, l); } else { PHB(PH_DATT, l); PHB(PH_COMB, l); }
        PHB(PH_GEMM2, l); PHB(PH_GEMM3, l); PHB(PH_XATT, l); run_phase<PH_EXPCVT>(p, l, lds); __syncthreads(); PHB(PH_GEMM4, l);
        PHB(PH_ROUTE, l); PHB(PH_MOE1, l); PHB(PH_MOE2, l);
        if (l == DEPTH - 1) run_phase<PH_FIN>(p, l, lds); else PHB(PH_FIN, l);
    }
#undef PHB
}

extern "C" void kernel_launch(void* const* d_in, const int* in_sizes, int n_in, void* d_out, int out_size, void* d_ws, size_t ws_size, hipStream_t stream) {
    if (n_in != 27 || ws_size < WS_END) { fprintf(stderr, "kernel_launch: unexpected n_in %d or ws_size %zu\n", n_in, ws_size); return; }
    Params p{};
    const float** pp = (const float**)&p;
    for (int i = 0; i < 27; ++i) pp[i] = (const float*)d_in[i];
    p.out = (float*)d_out; p.ws = (unsigned char*)d_ws;
    (void)hipMemsetAsync((char*)d_ws + WS_CTL, 0, 1 * MiB, stream);
    static int grid = 0;
    if (grid == 0) {
        int dev = 0, cus = 0, per_cu = 0;
        if (hipGetDevice(&dev) != hipSuccess || hipDeviceGetAttribute(&cus, hipDeviceAttributeMultiprocessorCount, dev) != hipSuccess) { grid = -1; return; }
        if (hipFuncSetAttribute((const void*)k_mega, hipFuncAttributeMaxDynamicSharedMemorySize, LDS_BYTES) != hipSuccess) { fprintf(stderr, "hipFuncSetAttribute failed\n"); grid = -1; return; }
        if (hipOccupancyMaxActiveBlocksPerMultiprocessor(&per_cu, (const void*)k_mega, NT, LDS_BYTES) != hipSuccess || per_cu < 1) { fprintf(stderr, "occupancy query: %d\n", per_cu); grid = -1; return; }
        (void)hipGetLastError();
        grid = cus;
    }
    if (grid < 0) return;
    hipLaunchKernelGGL(k_mega, dim3(grid), dim3(NT), LDS_BYTES, stream, p);
}
```

```cpp
#include <hip/hip_runtime.h>
#include <cstdio>
#include <cstdint>

typedef unsigned short bf16;
#define LAS __attribute__((address_space(3)))
typedef short bf16x8 __attribute__((ext_vector_type(8)));
typedef float f32x4 __attribute__((ext_vector_type(4)));
typedef float f32x16 __attribute__((ext_vector_type(16)));
typedef unsigned u32x4 __attribute__((ext_vector_type(4)));
typedef unsigned u32x2 __attribute__((ext_vector_type(2)));

constexpr int S = 16384, D = 1024, DEPTH = 4, MEM = 256;
constexpr int EVEN_IN = 1792, ODD_IN = 9216;
constexpr int NT = 512;
constexpr int LCAP = 16384;
constexpr size_t MiB = 1u << 20;
constexpr size_t WS_CTL = 0;
constexpr size_t WS_H = 1 * MiB;
constexpr size_t WS_HB = 65 * MiB;
constexpr size_t WS_Y = 97 * MiB;
constexpr size_t WS_Z = 129 * MiB;
constexpr size_t WS_WNX = 417 * MiB;
constexpr size_t WS_WEX = 484 * MiB;
constexpr size_t WS_MISC = 532 * MiB;
constexpr size_t WS_END = 548 * MiB;
constexpr size_t MISC_BTE = 0;
constexpr size_t MISC_BTO = 16384;
constexpr size_t MISC_SGW = 65536;
constexpr size_t MISC_MEMN = 1 * MiB;
constexpr size_t MISC_KV = 3 * MiB;
constexpr size_t MISC_LIST = 5 * MiB;
constexpr size_t MISC_GW = 6 * MiB;
constexpr size_t MISC_RSC = 6 * MiB + 131072;
constexpr size_t MISC_SSQ = 7 * MiB;
constexpr size_t MISC_LSE = 8 * MiB;
constexpr size_t MISC_WRT = 10 * MiB;
constexpr size_t Z_QX = 0;
constexpr size_t Z_OX = 16 * MiB;
constexpr size_t Z_HID = 32 * MiB;
constexpr size_t Z_VN = 64 * MiB;
constexpr size_t Z_YS = 96 * MiB;
constexpr size_t W1E_SZ = (size_t)EVEN_IN * D, W2_SZ = (size_t)D * D, W1O_SZ = (size_t)ODD_IN * D, WQ_SZ = (size_t)512 * D, WKV_SZ = (size_t)1024 * D, WO_SZ = (size_t)D * 512;
constexpr size_t WO_W1E = 0, WO_W2E = WO_W1E + 2 * W1E_SZ, WO_W1O = WO_W2E + 2 * W2_SZ, WO_W2O = WO_W1O + 2 * W1O_SZ, WO_WQ = WO_W2O + 2 * W2_SZ, WO_WKV = WO_WQ + 4 * WQ_SZ, WO_WO = WO_WKV + 4 * WKV_SZ, WO_END = WO_WO + 4 * WO_SZ;
static_assert(WO_END * 2 <= 67 * MiB, "non-expert weights fit");
constexpr size_t WGU_SZ = (size_t)1024 * 1024, WD_SZ = (size_t)1024 * 512;
constexpr size_t WEX_WD = 16 * WGU_SZ;
constexpr int CW_CNT = 1024;
constexpr int CW_BAR = 8192;
constexpr int LDS_BYTES = 147456;
constexpr int LDS_BARW = 131072;
constexpr int LDS_MOE = 131072 + 64;

struct Params {
    const float *x, *mem, *ln_mix, *ln_cross, *ln_mem, *ln_ffn, *ln_final, *rel_table,
        *even_w_in, *even_w_out, *sgu_ln_g, *sgu_ln_b, *sgu_w, *sgu_b, *attn_sink,
        *odd_w_in, *odd_w_out, *xq_w, *xkv_w, *xo_w, *rgw, *rgb, *rew, *reb, *ewg, *ewu, *ewd;
    float* out;
    unsigned char* ws;
};

__device__ __forceinline__ int otid() { int t = threadIdx.x; asm volatile("" : "+v"(t)); return t; }
__device__ __forceinline__ int obid() { int t = blockIdx.x; asm volatile("" : "+s"(t)); return t; }
__device__ __forceinline__ float bf2f(bf16 b) { return __uint_as_float(((unsigned)b) << 16); }
__device__ __forceinline__ bf16 f2bf(float f) { unsigned u = __float_as_uint(f); u += 0x7fffu + ((u >> 16) & 1u); return (bf16)(u >> 16); }
__device__ __forceinline__ unsigned cvt_pk_bf16(float lo, float hi) { unsigned r; asm volatile("v_cvt_pk_bf16_f32 %0, %1, %2" : "=v"(r) : "v"(lo), "v"(hi)); return r; }
__device__ __forceinline__ float wave_sum(float v) {
#pragma unroll
    for (int o = 1; o < 64; o <<= 1) v += __shfl_xor(v, o);
    return v;
}
__device__ __forceinline__ float gelu_tanh(float x) {
    const float u2 = 1.5957691216057308f * (x + 0.044715f * x * x * x);
    return x * __builtin_amdgcn_rcpf(1.0f + __expf(-u2));
}
__device__ __forceinline__ int t5_bucket(int rel) {
    const int ret = rel > 0 ? 16 : 0;
    const int n = rel < 0 ? -rel : rel;
    if (n < 8) return ret + n;
    const float nf = (float)n;
    int large = 8 + (int)(logf(nf / 8.0f) / 4.852030263919617f * 8.0f);
    large = large < 15 ? large : 15;
    return ret + large;
}

#define XB_TMO      128
#define XB_XCNT(j)  (256  + 64 * (j))
#define XB_XSUB(j)  (1280 + 64 * (j))
#define XB_XGEN(j)  (2304 + 64 * (j))
#define XB_TOP      3328
#define XB_TOPGEN   3392
#define XCD_BAR_WORDS 3456
#define XB_SPIN_CAP (1u << 22)
__device__ __forceinline__ unsigned xb_ld(unsigned* p)              { return __hip_atomic_load(p, __ATOMIC_RELAXED, __HIP_MEMORY_SCOPE_AGENT); }
__device__ __forceinline__ unsigned xb_add(unsigned* p, unsigned v) { return __hip_atomic_fetch_add(p, v, __ATOMIC_RELAXED, __HIP_MEMORY_SCOPE_AGENT); }
__device__ __forceinline__ unsigned xb_xcc_id() { return (unsigned)__builtin_amdgcn_s_getreg((3 << 11) | 20) & 0xFu; }
#define XB_SPIN(cond, bar) do { unsigned _sp = 0; while (cond) { __builtin_amdgcn_s_sleep(1); \
    if ((++_sp & 255u) == 0u) { if (xb_ld(&(bar)[XB_TMO])) break; if (_sp > XB_SPIN_CAP) { atomicAdd(&(bar)[XB_TMO], 1u); break; } } } } while (0)
struct XcdBarrier { unsigned* bar; unsigned x; volatile LAS unsigned* st; };
__device__ __forceinline__ XcdBarrier xcd_barrier_post(unsigned* bar, volatile LAS unsigned* st) {
    XcdBarrier b; b.bar = bar; b.x = (unsigned)__builtin_amdgcn_readfirstlane((int)xb_xcc_id()); b.st = st;
    if (threadIdx.x == 0) (void)xb_add(&bar[XB_XCNT(b.x)], 1u);
    return b;
}
__device__ __forceinline__ void xcd_barrier_complete(unsigned* bar, unsigned x, unsigned& nloc, unsigned& nx) {
    const unsigned G = gridDim.x * gridDim.y * gridDim.z;
    unsigned sum, cnt, mine, sp = 0u;
    for (;;) {
        sum = 0u; cnt = 0u; mine = 0u;
#pragma unroll
        for (unsigned j = 0; j < 16; ++j) { const unsigned c = xb_ld(&bar[XB_XCNT(j)]); sum += c; cnt += (c > 0u) ? 1u : 0u; mine = (j == x) ? c : mine; }
        if (sum == G) break;
        __builtin_amdgcn_s_sleep(1);
        if ((++sp & 255u) == 0u) { if (xb_ld(&bar[XB_TMO])) break; if (sp > XB_SPIN_CAP) { atomicAdd(&bar[XB_TMO], 1u); break; } }
    }
    nloc = mine > 0u ? mine : 1u; nx = cnt > 0u ? cnt : 1u;
}
__device__ __forceinline__ void xcd_barrier(const XcdBarrier& b) {
    asm volatile("s_waitcnt vmcnt(0)" ::: "memory");
    __syncthreads();
    if (threadIdx.x == 0) {
        unsigned* bar = b.bar; unsigned bx = b.x; asm volatile("" : "+s"(bar), "+s"(bx));
        __builtin_amdgcn_s_waitcnt(0);
        unsigned nloc = b.st[0], nx = b.st[1];
        if (nloc == 0u) { xcd_barrier_complete(bar, bx, nloc, nx); b.st[0] = nloc; b.st[1] = nx; }
        const unsigned old = xb_add(&bar[XB_XSUB(bx)], 1u);
        const unsigned gen = old / nloc;
        if (old + 1u == (gen + 1u) * nloc) {
            __builtin_amdgcn_fence(__ATOMIC_RELEASE, "agent");
            asm volatile("s_waitcnt vmcnt(0)" ::: "memory");
            const unsigned og = xb_add(&bar[XB_TOP], 1u);
            const unsigned tg = og / nx;
            if (og + 1u == (tg + 1u) * nx) xb_add(&bar[XB_TOPGEN], 1u);
            else XB_SPIN(xb_ld(&bar[XB_TOPGEN]) == tg, bar);
            __builtin_amdgcn_fence(__ATOMIC_ACQUIRE, "agent");
            xb_add(&bar[XB_XGEN(bx)], 1u);
            asm volatile("s_waitcnt vmcnt(0)" ::: "memory");
        } else {
            XB_SPIN(xb_ld(&bar[XB_XGEN(bx)]) == gen, bar);
            __builtin_amdgcn_fence(__ATOMIC_ACQUIRE, "agent");
            asm volatile("s_waitcnt vmcnt(0)" ::: "memory");
        }
    }
    __syncthreads();
}

namespace pg8 {
constexpr int BM = 256, BK = 64, HALF = 128, HTB = HALF * BK * 2, STAGE_BYTES = 8 * HTB, NXCD = 8, WGM = 8;
__host__ __device__ __forceinline__ int lds_byte(int r, int c) { const int st = (r >> 4) * 2 + (c >> 5), rr = r & 15, cc = c & 31, ob = rr * 64 + cc * 2; return st * 1024 + (ob ^ (((ob >> 9) & 1) << 5)); }
__host__ __device__ __forceinline__ void stage_rc(int b, int& R, int& C) { const int st = b / 1024, sb = b % 1024, swz = sb ^ (((sb >> 9) & 1) << 5); R = (st >> 1) * 16 + swz / 64; C = (st & 1) * 32 + (swz % 64) / 2; }
__host__ __device__ __forceinline__ int perm32(int rho) { const int n = rho >> 4, i = rho & 15; return 8 * (i >> 2) + 4 * n + (i & 3); }
struct Unit { int pm, pn, e, rows; };

struct DenseSched {
    int nM, nN, nwg, G, c, K; const bf16* Bt;
    __device__ void init(int M, int N, int K_, const bf16* Bt_, int G_, int c_) { nM = M / BM; nN = N / BM; nwg = nM * nN; G = G_; c = c_; K = K_; Bt = Bt_; }
    __device__ __forceinline__ bool next(int i, Unit& u) const {
        const long L = (long)i * G + c; if (L >= nwg) return false;
        int wgid = (int)L; { const int q = nwg / NXCD, r = nwg % NXCD, xcd = wgid % NXCD, off = wgid / NXCD; wgid = (xcd < r ? xcd * (q + 1) : r * (q + 1) + (xcd - r) * q) + off; }
        const int nig = WGM * nN, gid = wgid / nig, fm = gid * WGM, gsz = (nM - fm) < WGM ? (nM - fm) : WGM;
        u.pm = fm + ((wgid % nig) % gsz); u.pn = (wgid % nig) / gsz; u.e = 0; u.rows = 256; return true;
    }
    __device__ __forceinline__ unsigned arow(const Unit& u, int r) const { return (unsigned)(u.pm * BM + r) * (unsigned)(K * 2); }
    __device__ __forceinline__ const char* bbase(const Unit& u) const { return (const char*)Bt + (size_t)u.pn * BM * K * 2; }
};
template <bool TOKEN_ROWS>
struct MoeSched {
    int nN, G, c, K; const bf16* Bt; size_t bstride; const int* list; const LAS int* moe;
    __device__ __forceinline__ bool next(int i, Unit& u) const {
        const int L = i * G + c; const int total = moe[16] * nN; if (L >= total) return false;
        const int rt = L / nN; u.pn = L % nN; int e = 0;
#pragma unroll
        for (int j = 1; j < 16; ++j) e = (rt >= moe[j]) ? j : e;
        u.e = e; u.pm = rt - moe[e]; const int left = moe[17 + e] - u.pm * BM; u.rows = left < BM ? left : BM; return true;
    }
    __device__ __forceinline__ unsigned arow(const Unit& u, int r) const {
        const int idx = r < u.rows ? r : u.rows - 1; const int slot = list[u.e * LCAP + u.pm * BM + idx];
        return (unsigned)(TOKEN_ROWS ? (slot >> 1) : slot) * (unsigned)(K * 2);
    }
    __device__ __forceinline__ const char* bbase(const Unit& u) const { return (const char*)Bt + ((size_t)u.e * bstride + (size_t)u.pn * BM * K) * 2; }
};

template <class Epi, class Sched>
__device__ __forceinline__ void gemm_phase(LAS unsigned char* lds, const bf16* Abase, const int K, const Sched& S, const Epi& E) {
    const int tid = otid(), wid = __builtin_amdgcn_readfirstlane(tid >> 6), lane = tid & 63, wr = wid >> 2, wc = wid & 3, fr = lane & 15, fq = lane >> 4;
    const int nt = K / BK;
    unsigned voffB[2];
#pragma unroll
    for (int i = 0; i < 2; ++i) { int R, C; stage_rc(tid * 16 + i * 8192, R, C); const int Rb = Epi::PERM ? ((R & ~31) + perm32(R & 31)) : R;
        voffB[i] = (unsigned)(Rb * K + C) * 2u; }
#define PG8_AOFFS(u, o0, o1) do { const int _t = otid(); _Pragma("unroll") for (int _i = 0; _i < 2; ++_i) { int _R, _C; stage_rc(_t * 16 + _i * 8192, _R, _C); \
        o0[_i] = S.arow(u, _R) + (unsigned)_C * 2u; o1[_i] = S.arow(u, HALF + _R) + (unsigned)_C * 2u; } } while (0)
    const size_t kstep = (size_t)(BK * 2);
    const size_t hstep = (size_t)HALF * K * 2;
    const unsigned ldsw = (unsigned)wid * 1024u;
    const int aoff = lds_byte(wr * 64 + fr, fq * 8), boff = lds_byte(wc * 32 + fr, fq * 8);
    const char* Ab = (const char*)Abase;
#define PG8_SA(b, h) (((b) * 2 + (h)) * HTB)
#define PG8_SB(b, h) ((4 + (b) * 2 + (h)) * HTB)
#define PG8_STAGE(bufoff, gbase, voff) do { _Pragma("unroll") for (int _i = 0; _i < 2; ++_i) \
        __builtin_amdgcn_global_load_lds((const unsigned*)((const char*)(gbase) + (voff)[_i]), (LAS unsigned*)(lds + (bufoff) + ldsw + _i * 8192), 16, 0, 0); } while (0)
#define PG8_LDA(dst, b, h) do { _Pragma("unroll") for (int m = 0; m < 4; ++m) _Pragma("unroll") for (int k = 0; k < 2; ++k) dst[m][k] = *(const LAS bf16x8*)(lds + PG8_SA(b, h) + aoff + m * 2048 + k * 1024); } while (0)
#define PG8_LDB(dst, b, h) do { _Pragma("unroll") for (int n = 0; n < 2; ++n) _Pragma("unroll") for (int k = 0; k < 2; ++k) dst[n][k] = *(const LAS bf16x8*)(lds + PG8_SB(b, h) + boff + n * 2048 + k * 1024); } while (0)
#define PG8_MMA(ai, bj, At, Bt) do { __builtin_amdgcn_s_setprio(1); _Pragma("unroll") for (int m = 0; m < 4; ++m) _Pragma("unroll") for (int n = 0; n < 2; ++n) _Pragma("unroll") for (int k = 0; k < 2; ++k) \
        acc[ai][bj][m][n] = __builtin_amdgcn_mfma_f32_16x16x32_bf16(Bt[n][k], At[m][k], acc[ai][bj][m][n], 0, 0, 0); __builtin_amdgcn_s_setprio(0); } while (0)
#define PG8_WAIT_V(n) asm volatile("s_waitcnt vmcnt(" #n ")" ::: "memory")
#define PG8_WAIT_L(n) asm volatile("s_waitcnt lgkmcnt(" #n ")" ::: "memory")
#define PG8_BAR __builtin_amdgcn_s_barrier()
#define PG8_SCHED __builtin_amdgcn_sched_barrier(0)
    Unit cur, nxt; int ui = 0;
    if (!S.next(0, cur)) return;
    f32x4 acc[2][2][4][2];
#pragma unroll
    for (int a = 0; a < 2; ++a)
#pragma unroll
        for (int b = 0; b < 2; ++b)
#pragma unroll
            for (int m = 0; m < 4; ++m)
#pragma unroll
                for (int n = 0; n < 2; ++n) acc[a][b][m][n] = (f32x4){0.f, 0.f, 0.f, 0.f};
    bf16x8 At[4][2], B0[2][2], B1[2][2];
    unsigned oA0[2], oA1[2], oN0[2], oN1[2];
    PG8_AOFFS(cur, oA0, oA1);
    const char* cB = S.bbase(cur);
    PG8_STAGE(PG8_SB(0, 0), cB, voffB); PG8_STAGE(PG8_SB(0, 1), cB + hstep, voffB); PG8_STAGE(PG8_SA(0, 0), Ab, oA0); PG8_STAGE(PG8_SA(0, 1), Ab, oA1);
    if (wr == 1) PG8_BAR;
    PG8_WAIT_V(2); PG8_BAR;
    PG8_STAGE(PG8_SB(1, 0), cB + kstep, voffB); PG8_STAGE(PG8_SA(1, 0), Ab + kstep, oA0); PG8_STAGE(PG8_SB(1, 1), cB + hstep + kstep, voffB);
    PG8_WAIT_V(6); PG8_BAR;
    for (;;) {
        const bool has_next = S.next(ui + 1, nxt);
        const char* nB = has_next ? S.bbase(nxt) : cB;
        if (has_next) {
            PG8_AOFFS(nxt, oN0, oN1);
        } else {
#pragma unroll
            for (int i = 0; i < 2; ++i) { oN0[i] = oA0[i]; oN1[i] = oA1[i]; }
        }
        for (int t = 0; t < nt; t += 2) {
            const bool last = (t == nt - 2);
            const char* a1 = Ab + (size_t)(t + 1) * kstep;
            const char* a2 = last ? Ab : Ab + (size_t)(t + 2) * kstep; const char* b2 = last ? nB : cB + (size_t)(t + 2) * kstep;
            const char* a3 = a2 + kstep; const char* b3 = b2 + kstep;
            unsigned p0[2], p1[2];
#pragma unroll
            for (int i = 0; i < 2; ++i) { p0[i] = last ? oN0[i] : oA0[i]; p1[i] = last ? oN1[i] : oA1[i]; }
            PG8_LDB(B0, 0, 0); PG8_LDB(B1, 0, 1); PG8_SCHED; PG8_LDA(At, 0, 0); PG8_STAGE(PG8_SA(1, 1), a1, oA1);
            PG8_WAIT_V(8); PG8_WAIT_L(0); PG8_BAR; PG8_MMA(0, 0, At, B0); PG8_MMA(0, 1, At, B1); PG8_BAR; PG8_SCHED;
            PG8_LDA(At, 0, 1); PG8_STAGE(PG8_SB(0, 0), b2, voffB); PG8_STAGE(PG8_SB(0, 1), b2 + hstep, voffB); PG8_STAGE(PG8_SA(0, 0), a2, p0);
            PG8_WAIT_V(8); PG8_WAIT_L(0); PG8_BAR; PG8_MMA(1, 0, At, B0); PG8_MMA(1, 1, At, B1); PG8_BAR; PG8_SCHED;
            PG8_LDB(B0, 1, 0); PG8_LDB(B1, 1, 1); PG8_SCHED; PG8_LDA(At, 1, 0); PG8_STAGE(PG8_SA(0, 1), a2, p1);
            PG8_WAIT_V(8); PG8_WAIT_L(0); PG8_BAR; PG8_MMA(0, 0, At, B0); PG8_MMA(0, 1, At, B1); PG8_BAR; PG8_SCHED;
            PG8_LDA(At, 1, 1); PG8_STAGE(PG8_SB(1, 0), b3, voffB); PG8_STAGE(PG8_SB(1, 1), b3 + hstep, voffB); PG8_STAGE(PG8_SA(1, 0), a3, p0);
            PG8_WAIT_V(8); PG8_WAIT_L(0); PG8_BAR; PG8_MMA(1, 0, At, B0); PG8_MMA(1, 1, At, B1); PG8_BAR; PG8_SCHED;
        }
        if (wr == 0) PG8_BAR;
        E(acc, cur, wr, wc, fr, fq);
        if (!has_next) break;
#pragma unroll
        for (int a = 0; a < 2; ++a)
#pragma unroll
            for (int b = 0; b < 2; ++b)
#pragma unroll
                for (int m = 0; m < 4; ++m)
#pragma unroll
                    for (int n = 0; n < 2; ++n) acc[a][b][m][n] = (f32x4){0.f, 0.f, 0.f, 0.f};
        cur = nxt; cB = nB; ++ui;
#pragma unroll
        for (int i = 0; i < 2; ++i) { oA0[i] = oN0[i]; oA1[i] = oN1[i]; }
        if (wr == 1) PG8_BAR;
    }
    PG8_WAIT_V(0);
    PG8_BAR;
#undef PG8_AOFFS
#undef PG8_SA
#undef PG8_SB
#undef PG8_STAGE
#undef PG8_LDA
#undef PG8_LDB
#undef PG8_MMA
#undef PG8_WAIT_V
#undef PG8_WAIT_L
#undef PG8_BAR
#undef PG8_SCHED
}

__device__ __forceinline__ float row_rs(const float* ssqp, int row, int fq) {
    const f32x4 pp = *(const f32x4*)(ssqp + (size_t)row * 16 + 4 * fq);
    float s = (pp[0] + pp[1]) + (pp[2] + pp[3]);
    s += __shfl_xor(s, 16); s += __shfl_xor(s, 32);
    return rsqrtf(s * (1.0f / 1024.0f) + 1e-6f);
}
struct EpiScaleBf16 {
    static constexpr bool PERM = true;
    bf16* O; int ldc; const float* ssqp; int gelu_tiles;
    __device__ __forceinline__ void operator()(const f32x4 (&acc)[2][2][4][2], const Unit& u, int wr, int wc, int fr, int fq) const {
        const int row0 = u.pm * BM + wr * 64 + fr, col0 = u.pn * BM + wc * 32 + 8 * fq;
        const bool gl = u.pn < gelu_tiles;
#pragma unroll
        for (int ai = 0; ai < 2; ++ai)
#pragma unroll
            for (int m = 0; m < 4; ++m) {
                const int row = row0 + ai * HALF + m * 16;
                const float rs = ssqp ? row_rs(ssqp, row, fq) : 1.0f;
                bf16* rowp = O + (size_t)row * ldc + col0;
#pragma unroll
                for (int bj = 0; bj < 2; ++bj) {
                    f32x4 v0 = acc[ai][bj][m][0] * rs, v1 = acc[ai][bj][m][1] * rs;
                    if (gl) {
#pragma unroll
                        for (int j = 0; j < 4; ++j) { v0[j] = gelu_tanh(v0[j]); v1[j] = gelu_tanh(v1[j]); }
                    }
                    u32x4 w; w.x = cvt_pk_bf16(v0[0], v0[1]); w.y = cvt_pk_bf16(v0[2], v0[3]); w.z = cvt_pk_bf16(v1[0], v1[1]); w.w = cvt_pk_bf16(v1[2], v1[3]);
                    *(u32x4*)(rowp + bj * HALF) = w;
                }
            }
    }
};
template <bool BASE_F32>
struct EpiResidual {
    static constexpr bool PERM = false;
    const float* basef; bf16* hb; float* ssqp;
    __device__ __forceinline__ void operator()(const f32x4 (&acc)[2][2][4][2], const Unit& u, int wr, int wc, int fr, int fq) const {
        const int row0 = u.pm * BM + wr * 64 + fr, col0 = u.pn * BM + wc * 32 + 4 * fq;
#pragma unroll
        for (int ai = 0; ai < 2; ++ai)
#pragma unroll
            for (int m = 0; m < 4; ++m) {
                const int row = row0 + ai * HALF + m * 16; const size_t off = (size_t)row * D + col0; float ss = 0.f;
#pragma unroll
                for (int bj = 0; bj < 2; ++bj)
#pragma unroll
                    for (int n = 0; n < 2; ++n) {
                        f32x4 hv;
                        if constexpr (BASE_F32) hv = *(const f32x4*)(basef + off + bj * HALF + n * 16);
                        else { const u32x2 b = *(const u32x2*)(hb + off + bj * HALF + n * 16); hv = (f32x4){__uint_as_float(b.x << 16), __uint_as_float(b.x & 0xffff0000u), __uint_as_float(b.y << 16), __uint_as_float(b.y & 0xffff0000u)}; }
                        hv = hv + acc[ai][bj][m][n];
                        u32x2 w; w.x = cvt_pk_bf16(hv[0], hv[1]); w.y = cvt_pk_bf16(hv[2], hv[3]); *(u32x2*)(hb + off + bj * HALF + n * 16) = w;
                        ss += (hv[0] * hv[0] + hv[1] * hv[1]) + (hv[2] * hv[2] + hv[3] * hv[3]);
                    }
                ss += __shfl_xor(ss, 16); ss += __shfl_xor(ss, 32);
                if (fq == 0) ssqp[(size_t)row * 16 + u.pn * 4 + wc] = ss;
                asm volatile("" ::: "memory");
            }
    }
};
struct EpiMoe1 {
    static constexpr bool PERM = true;
    bf16* hid; const int* list; const float* rsc; const float* gatew;
    __device__ __forceinline__ void operator()(const f32x4 (&acc)[2][2][4][2], const Unit& u, int wr, int wc, int fr, int fq) const {
        const int f0 = u.pn * 128 + wc * 16 + 4 * fq;
#pragma unroll
        for (int ai = 0; ai < 2; ++ai)
#pragma unroll
            for (int m = 0; m < 4; ++m) {
                const int r = ai * HALF + wr * 64 + m * 16 + fr; const bool valid = r < u.rows;
                const int slot = list[u.e * LCAP + u.pm * BM + (valid ? r : u.rows - 1)];
                const float sc = rsc[slot], gw = gatew[slot];
#pragma unroll
                for (int bj = 0; bj < 2; ++bj) {
                    const f32x4 g = acc[ai][bj][m][0] * sc, up = acc[ai][bj][m][1] * sc; f32x4 o;
#pragma unroll
                    for (int j = 0; j < 4; ++j) o[j] = g[j] * __builtin_amdgcn_rcpf(1.0f + __expf(-g[j])) * up[j] * gw;
                    u32x2 w; w.x = cvt_pk_bf16(o[0], o[1]); w.y = cvt_pk_bf16(o[2], o[3]);
                    if (valid) *(u32x2*)(hid + (size_t)slot * 512 + f0 + bj * 64) = w;
                }
            }
    }
};
struct EpiMoe2 {
    static constexpr bool PERM = true;
    bf16* ys; const int* list;
    __device__ __forceinline__ void operator()(const f32x4 (&acc)[2][2][4][2], const Unit& u, int wr, int wc, int fr, int fq) const {
        const int col0 = u.pn * BM + wc * 32 + 8 * fq;
#pragma unroll
        for (int ai = 0; ai < 2; ++ai)
#pragma unroll
            for (int m = 0; m < 4; ++m) {
                const int r = ai * HALF + wr * 64 + m * 16 + fr; const bool valid = r < u.rows;
                const int slot = list[u.e * LCAP + u.pm * BM + (valid ? r : u.rows - 1)];
#pragma unroll
                for (int bj = 0; bj < 2; ++bj) {
                    const f32x4 v0 = acc[ai][bj][m][0], v1 = acc[ai][bj][m][1];
                    u32x4 w; w.x = cvt_pk_bf16(v0[0], v0[1]); w.y = cvt_pk_bf16(v0[2], v0[3]); w.z = cvt_pk_bf16(v1[0], v1[1]); w.w = cvt_pk_bf16(v1[2], v1[3]);
                    if (valid) *(u32x4*)(ys + (size_t)slot * D + col0 + bj * HALF) = w;
                }
            }
    }
};
}


namespace att {
constexpr int SHM_T = 16384;
constexpr int OFF_V = 0, OFF_K = 2 * SHM_T, OFF_WS = 4 * SHM_T, OFF_TAB = 4 * SHM_T + 4096;
#define ATT_KSWZ(row, colB) ((row) * 256 + ((colB) ^ (((row) & 7) << 4)))
__device__ __forceinline__ int crow(int r, int hi) { return (r & 3) + 8 * (r >> 2) + 4 * hi; }
__device__ __forceinline__ int v_st(int k, int c) { const int kk = (k & ~0xC) | ((k & 4) << 1) | ((k & 8) >> 1); return ((kk >> 3) * 4 + (c >> 5)) * 512 + ((kk & 7) * 32 + (c & 31)) * 2; }
__device__ __forceinline__ int v_rd_base(int lane) { return ((lane & 3) << 3) | (((lane >> 2) & 3) << 6) | (((lane >> 4) & 1) << 5) | (((lane >> 5) & 1) << 8); }
constexpr int v_rd_off(int d0, int ks, int half) { return d0 * 512 + ks * 4096 + half * 2048; }
typedef short s16x4 __attribute__((ext_vector_type(4)));
template <int OFF> __device__ __forceinline__ s16x4 tr_read(int vb) {
    s16x4 r; asm volatile("ds_read_b64_tr_b16 %0, %1 offset:%2" : "=&v"(r) : "v"(vb), "i"(OFF) : "memory"); return r;
}
template <int D0> __device__ __forceinline__ void pv_one(f32x16& od, int vb, bf16x8 pa0, bf16x8 pa1, bf16x8 pa2, bf16x8 pa3) {
    const s16x4 l0 = tr_read<v_rd_off(D0, 0, 0)>(vb), h0 = tr_read<v_rd_off(D0, 0, 1)>(vb), l1 = tr_read<v_rd_off(D0, 1, 0)>(vb), h1 = tr_read<v_rd_off(D0, 1, 1)>(vb);
    const s16x4 l2 = tr_read<v_rd_off(D0, 2, 0)>(vb), h2 = tr_read<v_rd_off(D0, 2, 1)>(vb), l3 = tr_read<v_rd_off(D0, 3, 0)>(vb), h3 = tr_read<v_rd_off(D0, 3, 1)>(vb);
    asm volatile("s_waitcnt lgkmcnt(0)" ::: "memory"); __builtin_amdgcn_sched_barrier(0);
#define ATT_PK(L, H) (bf16x8){L[0], L[1], L[2], L[3], H[0], H[1], H[2], H[3]}
    od = __builtin_amdgcn_mfma_f32_32x32x16_bf16(pa0, ATT_PK(l0, h0), od, 0, 0, 0);
    od = __builtin_amdgcn_mfma_f32_32x32x16_bf16(pa1, ATT_PK(l1, h1), od, 0, 0, 0);
    od = __builtin_amdgcn_mfma_f32_32x32x16_bf16(pa2, ATT_PK(l2, h2), od, 0, 0, 0);
    od = __builtin_amdgcn_mfma_f32_32x32x16_bf16(pa3, ATT_PK(l3, h3), od, 0, 0, 0);
#undef ATT_PK
}
template <int DK16, int DV32, bool MASK, int HALFWIN, class P>
__device__ __forceinline__ void attn_unit(LAS unsigned char* lds, const P& c, const int ntiles, const float C) {
    const int tid = otid(), wid = __builtin_amdgcn_readfirstlane(tid >> 6), lane = tid & 63, r32 = lane & 31, hi = lane >> 5;
    LAS unsigned char* V_lds = lds + OFF_V; LAS unsigned char* K_lds = lds + OFF_K;
    LAS float* wsf = (LAS float*)(lds + OFF_WS) + wid * 64; LAS float* li_l = wsf; LAS float* al_l = wsf + 32;
    bf16x8 qr[DK16];
    { const bf16* qp = c.q_ptr(wid, r32) + hi * 8;
#pragma unroll
      for (int d0 = 0; d0 < DK16; ++d0) qr[d0] = *(const bf16x8*)(qp + d0 * 16); }
    float m_reg = c.m0(wid), l_reg = c.l0(wid);
    f32x16 o[DV32];
#pragma unroll
    for (int d = 0; d < DV32; ++d)
#pragma unroll
        for (int r = 0; r < 16; ++r) o[d][r] = 0.f;
    constexpr bool D128 = (DK16 == 8);
    const int sr = D128 ? (tid >> 4) : (tid >> 3), sc = D128 ? (tid & 15) * 8 : (tid & 7) * 8;
    const int vst0 = v_st(sr, sc), vst1 = v_st(32 + sr, sc), kst0 = ATT_KSWZ(sr, sc * 2), kst1 = ATT_KSWZ(32 + sr, sc * 2);
    const int vb0 = (int)(unsigned)(uintptr_t)V_lds + v_rd_base(lane);
    bf16x8 ks0, ks1, vs0, vs1;
#define ATT_LOAD(t) do { const int _j = 64 * (t) + sr; ks0 = *(const bf16x8*)(c.k_ptr(_j) + sc); vs0 = *(const bf16x8*)(c.v_ptr(_j) + sc); \
        if (D128) { ks1 = *(const bf16x8*)(c.k_ptr(_j + 32) + sc); vs1 = *(const bf16x8*)(c.v_ptr(_j + 32) + sc); } } while (0)
#define ATT_WRITE(b) do { *(LAS bf16x8*)(V_lds + (b) * SHM_T + vst0) = vs0; *(LAS bf16x8*)(K_lds + (b) * SHM_T + kst0) = ks0; \
        if (D128) { *(LAS bf16x8*)(V_lds + (b) * SHM_T + vst1) = vs1; *(LAS bf16x8*)(K_lds + (b) * SHM_T + kst1) = ks1; } } while (0)
    ATT_LOAD(0); ATT_WRITE(0); __syncthreads();
    for (int t = 0; t < ntiles; ++t) {
        const int b = t & 1;
        if (t + 1 < ntiles) ATT_LOAD(t + 1);
        if (c.active(wid, t)) {
            f32x16 p0, p1;
#pragma unroll
            for (int r = 0; r < 16; ++r) { p0[r] = 0.f; p1[r] = 0.f; }
            const LAS unsigned char* Ks = K_lds + b * SHM_T;
#pragma unroll
            for (int d0 = 0; d0 < DK16; ++d0) { const int cb = (d0 * 16 + hi * 8) * 2;
                const bf16x8 b0 = *(const LAS bf16x8*)(Ks + ATT_KSWZ(r32, cb)); const bf16x8 b1 = *(const LAS bf16x8*)(Ks + ATT_KSWZ(32 + r32, cb));
                p0 = __builtin_amdgcn_mfma_f32_32x32x16_bf16(b0, qr[d0], p0, 0, 0, 0);
                p1 = __builtin_amdgcn_mfma_f32_32x32x16_bf16(b1, qr[d0], p1, 0, 0, 0); }
            if constexpr (MASK) {
                const int db = c.dbase(wid, r32, t) + 4 * hi, qi = c.qidx(wid, r32); const unsigned L = (unsigned)c.seqlen();
                const LAS float* tb = c.tab(wid) + (db + HALFWIN);
#pragma unroll
                for (int r = 0; r < 16; ++r) { const int dc = (r & 3) + 8 * (r >> 2);
                    { const int d = db + dc; const bool ok = ((unsigned)(d + HALFWIN) <= (unsigned)(2 * HALFWIN)) && ((unsigned)(qi + d) < L); const float tv = tb[dc];
                      p0[r] = ok ? fmaf(p0[r], C, tv) : -__builtin_inff(); }
                    { const int d = db + dc + 32; const bool ok = ((unsigned)(d + HALFWIN) <= (unsigned)(2 * HALFWIN)) && ((unsigned)(qi + d) < L); const float tv = tb[dc + 32];
                      p1[r] = ok ? fmaf(p1[r], C, tv) : -__builtin_inff(); } }
            } else {
#pragma unroll
                for (int r = 0; r < 16; ++r) { p0[r] *= C; p1[r] *= C; }
            }
            float pmax = p0[0];
#pragma unroll
            for (int r = 1; r < 16; ++r) pmax = fmaxf(pmax, p0[r]);
#pragma unroll
            for (int r = 0; r < 16; ++r) pmax = fmaxf(pmax, p1[r]);
            { auto rr = __builtin_amdgcn_permlane32_swap(__float_as_uint(pmax), __float_as_uint(pmax), false, false);
              pmax = fmaxf(__uint_as_float(rr[0]), __uint_as_float(rr[1])); }
            const float mn = fmaxf(m_reg, pmax), alpha = __builtin_amdgcn_exp2f(m_reg - mn); m_reg = mn;
            float ps = 0.f;
#pragma unroll
            for (int r = 0; r < 16; ++r) { p0[r] = __builtin_amdgcn_exp2f(p0[r] - mn); p1[r] = __builtin_amdgcn_exp2f(p1[r] - mn); ps += p0[r] + p1[r]; }
            { auto rr = __builtin_amdgcn_permlane32_swap(__float_as_uint(ps), __float_as_uint(ps), false, false);
              ps = __uint_as_float(rr[0]) + __uint_as_float(rr[1]); }
            l_reg = l_reg * alpha + ps;
            bf16x8 pa0, pa1, pa2, pa3;
#define ATT_PK4(Pv, BASE, OUT) do { const unsigned a0 = cvt_pk_bf16(Pv[BASE + 0], Pv[BASE + 1]), a1 = cvt_pk_bf16(Pv[BASE + 2], Pv[BASE + 3]); \
        const unsigned b0_ = cvt_pk_bf16(Pv[BASE + 4], Pv[BASE + 5]), b1_ = cvt_pk_bf16(Pv[BASE + 6], Pv[BASE + 7]); \
        auto r0 = __builtin_amdgcn_permlane32_swap(a0, b0_, false, false); auto r1 = __builtin_amdgcn_permlane32_swap(a1, b1_, false, false); \
        u32x4 w = {r0[0], r1[0], r0[1], r1[1]}; OUT = *reinterpret_cast<bf16x8*>(&w); } while (0)
            ATT_PK4(p0, 0, pa0); ATT_PK4(p0, 8, pa1); ATT_PK4(p1, 0, pa2); ATT_PK4(p1, 8, pa3);
#undef ATT_PK4
            if (__any(alpha < 1.f)) { if (hi == 0) al_l[r32] = alpha; asm volatile("s_waitcnt lgkmcnt(0)" ::: "memory");
#pragma unroll
                for (int r = 0; r < 16; ++r) { const float a = al_l[crow(r, hi)];
#pragma unroll
                    for (int d = 0; d < DV32; ++d) o[d][r] *= a; } }
            const int vb = vb0 + b * SHM_T;
            pv_one<0>(o[0], vb, pa0, pa1, pa2, pa3); pv_one<1>(o[1], vb, pa0, pa1, pa2, pa3);
            if constexpr (DV32 == 4) { pv_one<2>(o[2], vb, pa0, pa1, pa2, pa3); pv_one<3>(o[3], vb, pa0, pa1, pa2, pa3); }
        }
        if (t + 1 < ntiles) ATT_WRITE((t + 1) & 1);
        __syncthreads();
    }
#undef ATT_LOAD
#undef ATT_WRITE
    if (hi == 0) li_l[r32] = l_reg; asm volatile("s_waitcnt lgkmcnt(0)" ::: "memory");
    if (hi == 0) c.lse_store(wid, r32, (m_reg + __builtin_amdgcn_logf(l_reg)) * 0.6931471805599453f);
#pragma unroll
    for (int r = 0; r < 16; ++r) { const int orow = crow(r, hi); const float rl = __builtin_amdgcn_rcpf(li_l[orow]); bf16* op = c.out_ptr(wid, orow) + r32;
#pragma unroll
        for (int d = 0; d < DV32; ++d) op[d * 32] = f2bf(o[d][r] * rl); }
    asm volatile("s_waitcnt lgkmcnt(0)" ::: "memory");
}
#undef ATT_KSWZ

struct XattP {
    const bf16* qx; const bf16* kv; bf16* ox; int q0, h;
    __device__ __forceinline__ const bf16* q_ptr(int w, int r32) const { return qx + (size_t)(q0 + 32 * w + r32) * 512 + h * 128; }
    __device__ __forceinline__ const bf16* k_ptr(int j) const { return kv + (size_t)j * 1024 + h * 128; }
    __device__ __forceinline__ const bf16* v_ptr(int j) const { return kv + (size_t)j * 1024 + 512 + h * 128; }
    __device__ __forceinline__ bool active(int, int) const { return true; }
    __device__ __forceinline__ int dbase(int, int, int) const { return 0; }
    __device__ __forceinline__ int qidx(int, int) const { return 0; }
    __device__ __forceinline__ int seqlen() const { return 0; }
    __device__ __forceinline__ float m0(int) const { return -1e30f; }
    __device__ __forceinline__ float l0(int) const { return 0.f; }
    __device__ __forceinline__ const LAS float* tab(int) const { return nullptr; }
    __device__ __forceinline__ bf16* out_ptr(int w, int row) const { return ox + (size_t)(q0 + 32 * w + row) * 512 + h * 128; }
    __device__ __forceinline__ void lse_store(int, int, float) const {}
};
struct DattP {
    bf16* z; float* lse; const LAS float* tb; int g, h, dil, r, i0, L; bf16* zo;
    __device__ __forceinline__ size_t rowoff(int idx) const { return (size_t)(idx * dil + r) * ODD_IN + g * 3072 + h * 128; }
    __device__ __forceinline__ const bf16* q_ptr(int w, int r32) const { return z + rowoff(i0 + 32 * w + r32); }
    __device__ __forceinline__ int kidx(int j) const { int jj = i0 - 64 + j; jj = jj < 0 ? 0 : jj; return jj > L - 1 ? L - 1 : jj; }
    __device__ __forceinline__ const bf16* k_ptr(int j) const { return z + rowoff(kidx(j)) + 1024; }
    __device__ __forceinline__ const bf16* v_ptr(int j) const { return z + rowoff(kidx(j)) + 2048; }
    __device__ __forceinline__ bool active(int w, int t) const { return t >= (w >> 1) && t <= (w >> 1) + 2; }
    __device__ __forceinline__ int dbase(int w, int r32, int t) const { return 64 * t - 64 - 32 * w - r32; }
    __device__ __forceinline__ int qidx(int w, int r32) const { return i0 + 32 * w + r32; }
    __device__ __forceinline__ int seqlen() const { return L; }
    __device__ __forceinline__ float m0(int) const { return -1e30f; }
    __device__ __forceinline__ float l0(int) const { return 0.f; }
    __device__ __forceinline__ const LAS float* tab(int) const { return tb; }
    __device__ __forceinline__ bf16* out_ptr(int w, int row) const { return zo ? zo + (size_t)((i0 + 32 * w + row) * dil + r) * D + h * 128 : z + rowoff(i0 + 32 * w + row); }
    __device__ __forceinline__ void lse_store(int w, int row, float v) const { lse[((size_t)g * S + (size_t)(i0 + 32 * w + row) * dil + r) * 8 + h] = v; }
};
struct WattP {
    const bf16* z; bf16* y; const LAS float* tb; const float* sink; int kv, q0;
    __device__ __forceinline__ const bf16* q_ptr(int w, int r32) const { return z + (size_t)(q0 + 32 * (w >> 2) + r32) * EVEN_IN + 1024 + (kv * 4 + (w & 3)) * 64; }
    __device__ __forceinline__ int kpos(int j) const { int jj = q0 - 128 + j; jj = jj < 0 ? 0 : jj; return jj > S - 1 ? S - 1 : jj; }
    __device__ __forceinline__ const bf16* k_ptr(int j) const { return z + (size_t)kpos(j) * EVEN_IN + 1536 + kv * 64; }
    __device__ __forceinline__ const bf16* v_ptr(int j) const { return z + (size_t)kpos(j) * EVEN_IN + 1664 + kv * 64; }
    __device__ __forceinline__ bool active(int, int) const { return true; }
    __device__ __forceinline__ int dbase(int w, int r32, int t) const { return 64 * t - 128 - 32 * (w >> 2) - r32; }
    __device__ __forceinline__ int qidx(int w, int r32) const { return q0 + 32 * (w >> 2) + r32; }
    __device__ __forceinline__ int seqlen() const { return S; }
    __device__ __forceinline__ float m0(int w) const { return sink[kv * 4 + (w & 3)] * 1.4426950408889634f; }
    __device__ __forceinline__ float l0(int) const { return 1.f; }
    __device__ __forceinline__ const LAS float* tab(int w) const { return tb + (w & 3) * 257; }
    __device__ __forceinline__ bf16* out_ptr(int w, int row) const { return y + (size_t)(q0 + 32 * (w >> 2) + row) * D + 512 + (kv * 4 + (w & 3)) * 64; }
    __device__ __forceinline__ void lse_store(int, int, float) const {}
};
}

template <class RM>
__device__ __forceinline__ void cvt_item(const float* W, int N, int K, const float* g, bf16* WT, RM rowmap, LAS float* scr, int kb, int nb, int lane) {
    const int k0 = 64 * kb, n0 = 32 * nb;
    float v[32];
#pragma unroll
    for (int i = 0; i < 32; ++i) { const int kk = 2 * i + (lane >> 5); v[i] = W[(size_t)(k0 + kk) * N + n0 + (lane & 31)]; }
    if (g) {
#pragma unroll
        for (int i = 0; i < 32; ++i) v[i] *= g[k0 + 2 * i + (lane >> 5)];
    }
#pragma unroll
    for (int i = 0; i < 32; ++i) { const int kk = 2 * i + (lane >> 5); scr[kk * 33 + (lane & 31)] = v[i]; }
    asm volatile("s_waitcnt lgkmcnt(0)" ::: "memory");
    const int c = lane & 7;
#pragma unroll
    for (int j = 0; j < 4; ++j) { const int n = (lane >> 3) + 8 * j; const LAS float* s = scr + (8 * c) * 33 + n;
        u32x4 o; o.x = cvt_pk_bf16(s[0 * 33], s[1 * 33]); o.y = cvt_pk_bf16(s[2 * 33], s[3 * 33]); o.z = cvt_pk_bf16(s[4 * 33], s[5 * 33]); o.w = cvt_pk_bf16(s[6 * 33], s[7 * 33]);
        *(u32x4*)(WT + (size_t)rowmap(n0 + n) * K + k0 + 8 * c) = o; }
    asm volatile("s_waitcnt lgkmcnt(0)" ::: "memory");
}
struct CvtCtx { int gw, NGW, base, lane; LAS float* scr; };
template <class RM>
__device__ __forceinline__ void cvt_matrix(CvtCtx& c, const float* W, int K, int N, const float* g, bf16* WT, RM rowmap) {
    const int nblk = N / 32, nitems = (K / 64) * nblk;
    int j0 = (c.gw - c.base) % c.NGW; if (j0 < 0) j0 += c.NGW;
    for (int j = j0; j < nitems; j += c.NGW) cvt_item(W, N, K, g, WT, rowmap, c.scr, j / nblk, j % nblk, c.lane);
    c.base = (c.base + nitems) % c.NGW;
}

__device__ __forceinline__ void rms_row_bf16(const float4 (&v)[4], float rs, const float* g, bf16* dst, int lane) {
#pragma unroll
    for (int j = 0; j < 4; ++j) { const float4 gg = g ? ((const float4*)g)[lane + 64 * j] : make_float4(1.f, 1.f, 1.f, 1.f);
        u32x2 w; w.x = cvt_pk_bf16(v[j].x * rs * gg.x, v[j].y * rs * gg.y); w.y = cvt_pk_bf16(v[j].z * rs * gg.z, v[j].w * rs * gg.w); ((u32x2*)dst)[lane + 64 * j] = w; }
}

enum Phase { PH_INIT = 0, PH_EXPCVT, PH_GEMM1, PH_SGU, PH_WATT, PH_DATT, PH_COMB, PH_GEMM2, PH_GEMM3, PH_XATT, PH_GEMM4, PH_ROUTE, PH_MOE1, PH_MOE2, PH_FIN };

template <int PH, bool PRB = false>
__device__ __forceinline__ void run_phase(const Params& p, int layer, LAS unsigned char* lds) {
    unsigned char* ws = p.ws;
    asm volatile("" : "+s"(ws), "+s"(layer));
    float* h = (float*)(ws + WS_H); bf16* hb = (bf16*)(ws + WS_HB); bf16* y = (bf16*)(ws + WS_Y); bf16* z = (bf16*)(ws + WS_Z);
    bf16* wnx = (bf16*)(ws + WS_WNX); bf16* wex = (bf16*)(ws + WS_WEX);
    float* bte = (float*)(ws + WS_MISC + MISC_BTE); float* bto = (float*)(ws + WS_MISC + MISC_BTO);
    bf16* memn = (bf16*)(ws + WS_MISC + MISC_MEMN); bf16* kvm = (bf16*)(ws + WS_MISC + MISC_KV);
    int* lists = (int*)(ws + WS_MISC + MISC_LIST); float* gatew = (float*)(ws + WS_MISC + MISC_GW); float* rsc = (float*)(ws + WS_MISC + MISC_RSC);
    float* ssqp = (float*)(ws + WS_MISC + MISC_SSQ);
    bf16* qx = (bf16*)(ws + WS_Z + Z_QX); bf16* ox = (bf16*)(ws + WS_Z + Z_OX); bf16* hid = (bf16*)(ws + WS_Z + Z_HID); bf16* ys = (bf16*)(ws + WS_Z + Z_YS); float* vn = (float*)(ws + WS_Z + Z_VN);
    unsigned* ctl = (unsigned*)(ws + WS_CTL);
    const int tid = otid(), lane = tid & 63, wv = tid >> 6; const int bid = obid();
    const int gtid = bid * NT + tid, GT = gridDim.x * NT;
    const int gw = bid * (NT / 64) + wv, NGW = gridDim.x * (NT / 64);
    const int il = layer >> 1;
    const bool even = (layer & 1) == 0;
    const int G = gridDim.x;

    if constexpr (PH == PH_INIT) {
        for (int i = gtid; i < 8 * 257; i += GT) { const int hh = i / 257, rel = i % 257 - 128; bte[i] = p.rel_table[t5_bucket(rel) * 8 + hh]; }
        for (int i = gtid; i < 3 * 8 * 129; i += GT) { const int g = i / (8 * 129), hh = (i / 129) % 8, j = i % 129 - 64; const int dil = g == 0 ? 1 : (g == 1 ? 4 : 16); bto[i] = p.rel_table[t5_bucket(j * dil) * 8 + hh]; }
        { bf16* sgwd = (bf16*)(ws + WS_MISC + MISC_SGW); for (int i = gtid; i < 2 * 4 * 128 * 128; i += GT) sgwd[i] = f2bf(p.sgu_w[i]); }
        {
            bf16* wrt = (bf16*)(ws + WS_MISC + MISC_WRT);
            for (int i = gtid; i < DEPTH * 32 * 1024; i += GT) { const int l = i >> 15, c = (i >> 10) & 31, k = i & 1023; const float gk = p.ln_ffn[l * D + k];
                wrt[i] = c < 4 ? f2bf(gk * p.rgw[((size_t)l * D + k) * 4 + c]) : (c < 20 ? f2bf(gk * p.rew[((size_t)l * D + k) * 16 + (c - 4)]) : (bf16)0); }
        }
        for (int r = gw; r < S; r += NGW) {
            const float4* s4 = (const float4*)(p.x + (size_t)r * D); float4 v[4]; float ss = 0.f;
#pragma unroll
            for (int j = 0; j < 4; ++j) { v[j] = s4[lane + 64 * j]; ss += v[j].x * v[j].x + v[j].y * v[j].y + v[j].z * v[j].z + v[j].w * v[j].w; }
            ss = wave_sum(ss);
            rms_row_bf16(v, 1.0f, nullptr, hb + (size_t)r * D, lane);
            if (lane < 16) ssqp[(size_t)r * 16 + lane] = lane == 0 ? ss : 0.f;
        }
        for (int r = gw; r < MEM; r += NGW) {
            const float4* s4 = (const float4*)(p.mem + (size_t)r * D); float4 v[4]; float ss = 0.f;
#pragma unroll
            for (int j = 0; j < 4; ++j) { v[j] = s4[lane + 64 * j]; ss += v[j].x * v[j].x + v[j].y * v[j].y + v[j].z * v[j].z + v[j].w * v[j].w; }
            const float rs = rsqrtf(wave_sum(ss) * (1.0f / D) + 1e-6f);
            for (int l = 0; l < DEPTH; ++l) rms_row_bf16(v, rs, p.ln_mem + l * D, memn + ((size_t)l * MEM + r) * D, lane);
        }
        CvtCtx c{gw, NGW, 0, lane, (LAS float*)(lds + wv * 16384)};
        auto idm = [](int n) { return n; };
        for (int i = 0; i < 2; ++i) {
            cvt_matrix(c, p.even_w_in + (size_t)i * D * EVEN_IN, D, EVEN_IN, p.ln_mix + (2 * i) * D, wnx + WO_W1E + i * W1E_SZ, idm);
            cvt_matrix(c, p.even_w_out + (size_t)i * D * D, D, D, nullptr, wnx + WO_W2E + i * W2_SZ, idm);
            cvt_matrix(c, p.odd_w_in + (size_t)i * D * ODD_IN, D, ODD_IN, p.ln_mix + (2 * i + 1) * D, wnx + WO_W1O + i * W1O_SZ, idm);
            cvt_matrix(c, p.odd_w_out + (size_t)i * D * D, D, D, nullptr, wnx + WO_W2O + i * W2_SZ, idm);
        }
        for (int l = 0; l < DEPTH; ++l) {
            cvt_matrix(c, p.xq_w + (size_t)l * D * 512, D, 512, p.ln_cross + l * D, wnx + WO_WQ + l * WQ_SZ, idm);
            cvt_matrix(c, p.xkv_w + (size_t)l * D * 1024, D, 1024, nullptr, wnx + WO_WKV + l * WKV_SZ, idm);
            cvt_matrix(c, p.xo_w + (size_t)l * 512 * D, 512, D, nullptr, wnx + WO_WO + l * WO_SZ, idm);
        }
    }
    if constexpr (PH == PH_EXPCVT) {
        CvtCtx c{gw, NGW, 0, lane, (LAS float*)(lds + wv * 16384)};
        const float* gf = p.ln_ffn + layer * D;
        for (int e = 0; e < 16; ++e) {
            cvt_matrix(c, p.ewg + ((size_t)layer * 16 + e) * D * 512, D, 512, gf, wex + e * WGU_SZ, [](int n) { return 8 * (n >> 2) + (n & 3); });
            cvt_matrix(c, p.ewu + ((size_t)layer * 16 + e) * D * 512, D, 512, gf, wex + e * WGU_SZ, [](int n) { return 8 * (n >> 2) + 4 + (n & 3); });
            cvt_matrix(c, p.ewd + ((size_t)layer * 16 + e) * 512 * D, 512, D, nullptr, wex + WEX_WD + e * WD_SZ, [](int n) { return n; });
        }
    }
    if constexpr (PH == PH_GEMM1) {
        const int N = even ? EVEN_IN : ODD_IN;
        const bf16* W = even ? wnx + WO_W1E + il * W1E_SZ : wnx + WO_W1O + il * W1O_SZ;
        pg8::DenseSched Sd; Sd.init(S, N, D, W, G, bid);
        pg8::EpiScaleBf16 E{z, N, ssqp, even ? 4 : 0};
        pg8::gemm_phase(lds, hb, D, Sd, E);
        if (layer == 0 && bid >= G - 16) {
            const int uidx = bid - (G - 16), l = uidx >> 2;
            pg8::DenseSched Sk; Sk.init(MEM, 1024, D, wnx + WO_WKV + l * WKV_SZ, 4, uidx & 3);
            pg8::EpiScaleBf16 Ek{kvm + (size_t)l * MEM * 1024, 1024, nullptr, 0};
            pg8::gemm_phase(lds, memn + (size_t)l * MEM * D, D, Sk, Ek);
        }
    }
    if constexpr (PH == PH_SGU) {
        const bf16* sgw = (const bf16*)(ws + WS_MISC + MISC_SGW) + (size_t)il * 4 * 128 * 128;
        const float* lg = p.sgu_ln_g + il * 512; const float* lb = p.sgu_ln_b + il * 512; const float* bs = p.sgu_b + il * 512;
        LAS unsigned char* vnt = lds + 77824;
        LAS float* st = (LAS float*)(lds + 77824 + 34816);
        const int wid = __builtin_amdgcn_readfirstlane(tid >> 6), r32 = lane & 31, hi = lane >> 5;
        for (int u = bid; u < 512; u += G) {
            const int g = u & 3, t0 = (u >> 2) * 128;
            {
                const int q = tid >> 2, part = tid & 3; const bf16* vp = z + (size_t)(t0 + q) * EVEN_IN + 512 + part * 128; float s = 0.f, s2 = 0.f;
#pragma unroll
                for (int i = 0; i < 16; ++i) { const u32x4 w = *(const u32x4*)(vp + 8 * i);
#pragma unroll
                    for (int k = 0; k < 4; ++k) { const float a = __uint_as_float(w[k] << 16), b = __uint_as_float(w[k] & 0xffff0000u); s += a + b; s2 += a * a + b * b; } }
                s += __shfl_xor(s, 1); s += __shfl_xor(s, 2); s2 += __shfl_xor(s2, 1); s2 += __shfl_xor(s2, 2);
                const float mu = s * (1.f / 512.f), var = s2 * (1.f / 512.f) - mu * mu;
                if (part == 0) { st[2 * q] = mu; st[2 * q + 1] = rsqrtf(fmaxf(var, 0.f) + 1e-6f); }
            }
            __syncthreads();
#pragma unroll
            for (int it = 0; it < 4; ++it) {
                const int item = tid + NT * it, q = item & 127, cc = item >> 7;
                const u32x4 w = *(const u32x4*)(z + (size_t)(t0 + q) * EVEN_IN + 512 + g * 128 + 8 * cc); const float mu = st[2 * q], rstd = st[2 * q + 1];
#pragma unroll
                for (int k = 0; k < 8; ++k) { const int c = 8 * cc + k; const float v = (k & 1) ? __uint_as_float(w[k >> 1] & 0xffff0000u) : __uint_as_float(w[k >> 1] << 16);
                    *(LAS bf16*)(vnt + c * 272 + q * 2) = f2bf((v - mu) * rstd * lg[g * 128 + c] + lb[g * 128 + c]); }
            }
            __syncthreads();
            const int pb = wid >> 1, cb0 = (wid & 1) * 2;
            bf16x8 af[8];
#pragma unroll
            for (int ks = 0; ks < 8; ++ks) af[ks] = *(const bf16x8*)(sgw + (size_t)(g * 128 + 32 * pb + r32) * 128 + 16 * ks + 8 * hi);
            f32x16 acc0, acc1;
#pragma unroll
            for (int r = 0; r < 16; ++r) { acc0[r] = 0.f; acc1[r] = 0.f; }
#pragma unroll
            for (int ks = 0; ks < 8; ++ks) {
                const bf16x8 b0 = *(const LAS bf16x8*)(vnt + (32 * cb0 + r32) * 272 + (16 * ks + 8 * hi) * 2);
                const bf16x8 b1 = *(const LAS bf16x8*)(vnt + (32 * (cb0 + 1) + r32) * 272 + (16 * ks + 8 * hi) * 2);
                acc0 = __builtin_amdgcn_mfma_f32_32x32x16_bf16(af[ks], b0, acc0, 0, 0, 0);
                acc1 = __builtin_amdgcn_mfma_f32_32x32x16_bf16(af[ks], b1, acc1, 0, 0, 0);
            }
#pragma unroll
            for (int r = 0; r < 16; ++r) {
                const int prow = 32 * pb + att::crow(r, hi), tok = t0 + prow; const float bias = bs[g * 128 + prow];
                const int col = g * 128 + 32 * cb0 + r32;
                y[(size_t)tok * D + col] = f2bf(bf2f(z[(size_t)tok * EVEN_IN + col]) * (acc0[r] + bias));
                y[(size_t)tok * D + col + 32] = f2bf(bf2f(z[(size_t)tok * EVEN_IN + col + 32]) * (acc1[r] + bias));
            }
            __syncthreads();
        }
    }
    if constexpr (PH == PH_WATT) {
        LAS float* tb = (LAS float*)(lds + att::OFF_TAB);
        for (int u = bid; u < (S / 64) * 2; u += G) {
            const int kv = u & 1, blk = u >> 1;
            for (int i = tid; i < 4 * 257; i += NT) tb[i] = bte[(kv * 4 + i / 257) * 257 + i % 257] * 1.4426950408889634f;
            att::WattP P{z, y, tb, p.attn_sink + il * 8, kv, blk * 64};
            att::attn_unit<4, 2, true, 128>(lds, P, 5, 0.125f * 1.4426950408889634f);
        }
    }
    if constexpr (PH == PH_DATT) {
        float* lse = (float*)(ws + WS_MISC + MISC_LSE);
        LAS float* tb = (LAS float*)(lds + att::OFF_TAB);
        for (int u = bid; u < 3 * 512; u += G) {
            const int g = u >> 9, uu = u & 511, hh = uu & 7, rest = uu >> 3;
            const int dil = g == 0 ? 1 : (g == 1 ? 4 : 16), r = rest % dil, blk = rest / dil;
            if (tid < 129) tb[tid] = bto[(g * 8 + hh) * 129 + tid] * 1.4426950408889634f;
            att::DattP P{z, PRB ? (float*)hb : lse, tb, g, hh, dil, r, blk * 256, S / dil, PRB ? y : nullptr};
            att::attn_unit<8, 4, true, 64>(lds, P, 6, 0.08838834764831845f * 1.4426950408889634f);
        }
    }
    if constexpr (PH == PH_COMB) {
        const float* lse = (const float*)(ws + WS_MISC + MISC_LSE);
        for (int i = gtid; i < S * 128; i += GT) {
            const int pos = i >> 7, ch = i & 127, hh = ch >> 4;
            const float l0 = lse[((size_t)0 * S + pos) * 8 + hh], l1 = lse[((size_t)1 * S + pos) * 8 + hh], l2 = lse[((size_t)2 * S + pos) * 8 + hh];
            const float mx = fmaxf(l0, fmaxf(l1, l2)); float w0 = __expf(l0 - mx), w1 = __expf(l1 - mx), w2 = __expf(l2 - mx); const float inv = 1.0f / (w0 + w1 + w2); w0 *= inv; w1 *= inv; w2 *= inv;
            const bf16* zr = z + (size_t)pos * ODD_IN + ch * 8;
            const u32x4 a = *(const u32x4*)zr, b = *(const u32x4*)(zr + 3072), c = *(const u32x4*)(zr + 6144); u32x4 o;
#pragma unroll
            for (int k = 0; k < 4; ++k) {
                const float lo = w0 * __uint_as_float(a[k] << 16) + w1 * __uint_as_float(b[k] << 16) + w2 * __uint_as_float(c[k] << 16);
                const float hi2 = w0 * __uint_as_float(a[k] & 0xffff0000u) + w1 * __uint_as_float(b[k] & 0xffff0000u) + w2 * __uint_as_float(c[k] & 0xffff0000u);
                o[k] = cvt_pk_bf16(lo, hi2); }
            *(u32x4*)(y + (size_t)pos * D + ch * 8) = o;
        }
    }
    if constexpr (PH == PH_GEMM2) {
        const bf16* W = even ? wnx + WO_W2E + il * W2_SZ : wnx + WO_W2O + il * W2_SZ;
        pg8::DenseSched Sd; Sd.init(S, D, D, W, G, bid);
        if (layer == 0) { pg8::EpiResidual<true> E{p.x, hb, ssqp}; pg8::gemm_phase(lds, y, D, Sd, E); }
        else { pg8::EpiResidual<false> E{nullptr, hb, ssqp}; pg8::gemm_phase(lds, y, D, Sd, E); }
    }
    if constexpr (PH == PH_GEMM3) {
        pg8::DenseSched Sd; Sd.init(S, 512, D, wnx + WO_WQ + layer * WQ_SZ, G, bid);
        pg8::EpiScaleBf16 E{qx, 512, ssqp, 0};
        pg8::gemm_phase(lds, hb, D, Sd, E);
    }
    if constexpr (PH == PH_XATT) {
        const bf16* kvl = kvm + (size_t)layer * MEM * 1024;
        for (int u = bid; u < (S / 256) * 4; u += G) {
            att::XattP P{qx, kvl, ox, (u >> 2) * 256, u & 3};
            att::attn_unit<8, 4, false, 64>(lds, P, 4, 0.08838834764831845f * 1.4426950408889634f);
        }
    }
    if constexpr (PH == PH_GEMM4) {
        pg8::DenseSched Sd; Sd.init(S, D, 512, wnx + WO_WO + layer * WO_SZ, G, bid);
        pg8::EpiResidual<false> E{nullptr, hb, ssqp};
        pg8::gemm_phase(lds, ox, 512, Sd, E);
    }
    if constexpr (PH == PH_ROUTE) {
        const bf16* wrt = (const bf16*)(ws + WS_MISC + MISC_WRT) + (size_t)layer * 32 * 1024;
        const float* bg = p.rgb + layer * 4; const float* be = p.reb + layer * 16;
        unsigned* cn = ctl + (PRB ? 65536 : CW_CNT); int* ls = PRB ? (int*)(ws + WS_Z + 160 * MiB) : lists; float* gwp = PRB ? (float*)(ws + WS_Z + 162 * MiB) : gatew; float* rsp = PRB ? (float*)(ws + WS_Z + 163 * MiB) : rsc;
        LAS float* lgt = (LAS float*)lds;
        LAS unsigned* lcnt = (LAS unsigned*)(lds + 16384);
        const int wid = __builtin_amdgcn_readfirstlane(tid >> 6), tg = wid >> 1, cb = wid & 1, l15 = lane & 15, kg = lane >> 4;
        for (int u = bid; u < S / 64; u += G) {
            const int t0 = u * 64;
            if (tid < 32) lcnt[tid] = 0u;
            f32x4 acc = (f32x4){0.f, 0.f, 0.f, 0.f};
            const bf16* ap = hb + (size_t)(t0 + 16 * tg + l15) * D + 8 * kg; const bf16* bp = wrt + (size_t)(16 * cb + l15) * 1024 + 8 * kg;
#pragma unroll 8
            for (int s = 0; s < 32; ++s) { const bf16x8 a = *(const bf16x8*)(ap + 32 * s), b = *(const bf16x8*)(bp + 32 * s); acc = __builtin_amdgcn_mfma_f32_16x16x32_bf16(a, b, acc, 0, 0, 0); }
#pragma unroll
            for (int r = 0; r < 4; ++r) lgt[(16 * tg + 4 * kg + r) * 33 + 16 * cb + l15] = acc[r];
            __syncthreads();
            int E0 = 0, E1 = 0; unsigned lp0 = 0, lp1 = 0; float g0 = 0.f, g1 = 0.f, rs = 0.f;
            if (tid < 64) {
                const int t = t0 + tid; float ssq = 0.f;
#pragma unroll
                for (int j = 0; j < 4; ++j) { const f32x4 q = *(const f32x4*)(ssqp + (size_t)t * 16 + 4 * j); ssq += (q[0] + q[1]) + (q[2] + q[3]); }
                rs = rsqrtf(ssq * (1.0f / D) + 1e-6f);
                float lg[4], le[16];
#pragma unroll
                for (int c = 0; c < 4; ++c) lg[c] = lgt[tid * 33 + c] * rs + bg[c];
#pragma unroll
                for (int c = 0; c < 16; ++c) le[c] = lgt[tid * 33 + 4 + c] * rs + be[c];
                int grp = 0; float gm = lg[0];
#pragma unroll
                for (int c = 1; c < 4; ++c) if (lg[c] > gm) { gm = lg[c]; grp = c; }
                float gs = 0.f;
#pragma unroll
                for (int c = 0; c < 4; ++c) gs += __expf(lg[c] - gm);
                const float ggate = 1.0f / gs;
                float es[4];
#pragma unroll
                for (int e = 0; e < 4; ++e) es[e] = grp == 0 ? le[e] : (grp == 1 ? le[4 + e] : (grp == 2 ? le[8 + e] : le[12 + e]));
                int i0 = 0; float v0 = es[0];
#pragma unroll
                for (int e = 1; e < 4; ++e) if (es[e] > v0) { v0 = es[e]; i0 = e; }
                int i1 = -1; float v1 = -3.0e38f;
#pragma unroll
                for (int e = 0; e < 4; ++e) if (e != i0 && es[e] > v1) { v1 = es[e]; i1 = e; }
                const float ex = __expf(v1 - v0); g0 = ggate / (1.0f + ex); g1 = ggate * ex / (1.0f + ex);
                E0 = grp * 4 + i0; E1 = grp * 4 + i1;
                lp0 = __hip_atomic_fetch_add(lcnt + E0, 1u, __ATOMIC_RELAXED, __HIP_MEMORY_SCOPE_WORKGROUP);
                lp1 = __hip_atomic_fetch_add(lcnt + E1, 1u, __ATOMIC_RELAXED, __HIP_MEMORY_SCOPE_WORKGROUP);
            }
            __syncthreads();
            if (tid < 16) { const unsigned c = lcnt[tid]; lcnt[16 + tid] = c ? atomicAdd(&cn[(layer * 16 + tid) * 64], c) : 0u; }
            __syncthreads();
            if (tid < 64) {
                const int t = t0 + tid;
                ls[E0 * LCAP + lcnt[16 + E0] + lp0] = 2 * t; ls[E1 * LCAP + lcnt[16 + E1] + lp1] = 2 * t + 1;
                gwp[2 * t] = g0; gwp[2 * t + 1] = g1; rsp[2 * t] = rs; rsp[2 * t + 1] = rs;
            }
            __syncthreads();
        }
    }
    if constexpr (PH == PH_MOE1 || PH == PH_MOE2) {
        LAS int* moe = (LAS int*)(lds + LDS_MOE);
        if (tid == 0) { int acc = 0; for (int e = 0; e < 16; ++e) { const int c = (int)ctl[CW_CNT + (layer * 16 + e) * 64]; moe[e] = acc; moe[17 + e] = c; acc += (c + 255) >> 8; } moe[16] = acc; }
        __syncthreads();
        if constexpr (PH == PH_MOE1) {
            pg8::MoeSched<true> Sm{4, G, bid, D, wex, WGU_SZ, lists, moe};
            pg8::EpiMoe1 E{hid, lists, rsc, gatew};
            pg8::gemm_phase(lds, hb, D, Sm, E);
        } else {
            pg8::MoeSched<false> Sm{4, G, bid, 512, wex + WEX_WD, WD_SZ, lists, moe};
            pg8::EpiMoe2 E{ys, lists};
            pg8::gemm_phase(lds, hid, 512, Sm, E);
        }
        __syncthreads();
    }
    if constexpr (PH == PH_FIN) {
        bf16* hbo = PRB ? (bf16*)(ws + WS_Z + 224 * MiB) : hb; float* sso = PRB ? (float*)(ws + WS_Z + 260 * MiB) : ssqp;
        for (int r = gw; r < S; r += NGW) {
            float4 v[4]; float ss = 0.f;
            const u32x2* hr = (const u32x2*)(hb + (size_t)r * D);
            const u32x2* y0 = (const u32x2*)(ys + (size_t)(2 * r) * D); const u32x2* y1 = (const u32x2*)(ys + (size_t)(2 * r + 1) * D);
#pragma unroll
            for (int j = 0; j < 4; ++j) {
                const u32x2 c = hr[lane + 64 * j], a = y0[lane + 64 * j], b = y1[lane + 64 * j];
                v[j].x = __uint_as_float(c.x << 16) + (__uint_as_float(a.x << 16) + __uint_as_float(b.x << 16)); v[j].y = __uint_as_float(c.x & 0xffff0000u) + (__uint_as_float(a.x & 0xffff0000u) + __uint_as_float(b.x & 0xffff0000u));
                v[j].z = __uint_as_float(c.y << 16) + (__uint_as_float(a.y << 16) + __uint_as_float(b.y << 16)); v[j].w = __uint_as_float(c.y & 0xffff0000u) + (__uint_as_float(a.y & 0xffff0000u) + __uint_as_float(b.y & 0xffff0000u));
                ss += v[j].x * v[j].x + v[j].y * v[j].y + v[j].z * v[j].z + v[j].w * v[j].w;
            }
            ss = wave_sum(ss);
            if (layer == DEPTH - 1) {
                const float rs = rsqrtf(ss * (1.0f / D) + 1e-6f); float4* o4 = (float4*)(p.out + (size_t)r * D);
#pragma unroll
                for (int j = 0; j < 4; ++j) { const float4 gg = ((const float4*)p.ln_final)[lane + 64 * j]; float4 o; o.x = v[j].x * rs * gg.x; o.y = v[j].y * rs * gg.y; o.z = v[j].z * rs * gg.z; o.w = v[j].w * rs * gg.w; o4[lane + 64 * j] = o; }
            } else {
                rms_row_bf16(v, 1.0f, nullptr, hbo + (size_t)r * D, lane);
                if (lane < 16) sso[(size_t)r * 16 + lane] = lane == 0 ? ss : 0.f;
            }
        }
    }
}

__global__ void __launch_bounds__(NT, 2) k_mega(Params p) {
    extern __shared__ __attribute__((aligned(16))) unsigned char lds_[];
    LAS unsigned char* lds = (LAS unsigned char*)lds_;
    if (threadIdx.x < 4) ((LAS unsigned*)(lds + LDS_BARW))[threadIdx.x] = 0u;
    __syncthreads();
    XcdBarrier bar = xcd_barrier_post((unsigned*)(p.ws + WS_CTL) + CW_BAR, (volatile LAS unsigned*)(lds + LDS_BARW));
#ifndef PROBE_PH
#define PROBE_PH -1
#endif
#define PHX(PH, l, BAR) do { run_phase<PH>(p, l, lds); if (BAR) xcd_barrier(bar); else __syncthreads(); \
        if (PH == PROBE_PH) { run_phase<PH, true>(p, l, lds); if (BAR) xcd_barrier(bar); else __syncthreads(); } \
        if (PROBE_PH == -2 && (BAR)) xcd_barrier(bar); } while (0)
#define PHB(PH, l) PHX(PH, l, true)
    PHB(PH_INIT, 0);
    for (int l = 0; l < DEPTH; ++l) {
        PHB(PH_GEMM1, l);
        if ((l & 1) == 0) { PHX(PH_SGU, l, false); PHB(PH_WATT, l); } else { PHB(PH_DATT, l); PHB(PH_COMB, l); }
        PHB(PH_GEMM2, l); PHB(PH_GEMM3, l); PHB(PH_XATT, l); PHX(PH_EXPCVT, l, false); PHB(PH_GEMM4, l);
        PHB(PH_ROUTE, l); PHB(PH_MOE1, l); PHB(PH_MOE2, l);
        if (l == DEPTH - 1) run_phase<PH_FIN>(p, l, lds); else PHB(PH_FIN, l);
    }
#undef PHX
#undef PHB
}

extern "C" void kernel_launch(void* const* d_in, const int* in_sizes, int n_in, void* d_out, int out_size, void* d_ws, size_t ws_size, hipStream_t stream) {
    if (n_in != 27 || ws_size < WS_END) { fprintf(stderr, "kernel_launch: unexpected n_in %d or ws_size %zu\n", n_in, ws_size); return; }
    Params p{};
    const float** pp = (const float**)&p;
    for (int i = 0; i < 27; ++i) pp[i] = (const float*)d_in[i];
    p.out = (float*)d_out; p.ws = (unsigned char*)d_ws;
    (void)hipMemsetAsync((char*)d_ws + WS_CTL, 0, 1 * MiB, stream);
    static int grid = 0;
    if (grid == 0) {
        int dev = 0, cus = 0, per_cu = 0;
        if (hipGetDevice(&dev) != hipSuccess || hipDeviceGetAttribute(&cus, hipDeviceAttributeMultiprocessorCount, dev) != hipSuccess) { grid = -1; return; }
        if (hipFuncSetAttribute((const void*)k_mega, hipFuncAttributeMaxDynamicSharedMemorySize, LDS_BYTES) != hipSuccess) { fprintf(stderr, "hipFuncSetAttribute failed\n"); grid = -1; return; }
        if (hipOccupancyMaxActiveBlocksPerMultiprocessor(&per_cu, (const void*)k_mega, NT, LDS_BYTES) != hipSuccess || per_cu < 1) { fprintf(stderr, "occupancy query: %d\n", per_cu); grid = -1; return; }
        (void)hipGetLastError();
        grid = cus;
    }
    if (grid < 0) return;
    hipLaunchKernelGGL(k_mega, dim3(grid), dim3(NT), LDS_BYTES, stream, p);
}
```

```cpp
#include <hip/hip_runtime.h>
#include <cstdio>
#include <cstdint>

typedef unsigned short bf16;
#define LAS __attribute__((address_space(3)))
typedef short bf16x8 __attribute__((ext_vector_type(8)));
typedef float f32x4 __attribute__((ext_vector_type(4)));
typedef float f32x16 __attribute__((ext_vector_type(16)));
typedef unsigned u32x4 __attribute__((ext_vector_type(4)));
typedef unsigned u32x2 __attribute__((ext_vector_type(2)));

constexpr int S = 16384, D = 1024, DEPTH = 4, MEM = 256;
constexpr int EVEN_IN = 1792, ODD_IN = 9216;
constexpr int NT = 512;
constexpr int LCAP = 16384;
constexpr size_t MiB = 1u << 20;
constexpr size_t WS_CTL = 0;
constexpr size_t WS_H = 1 * MiB;
constexpr size_t WS_HB = 65 * MiB;
constexpr size_t WS_Y = 97 * MiB;
constexpr size_t WS_Z = 129 * MiB;
constexpr size_t WS_WNX = 417 * MiB;
constexpr size_t WS_WEX = 484 * MiB;
constexpr size_t WS_MISC = 532 * MiB;
constexpr size_t WS_END = 548 * MiB;
constexpr size_t MISC_BTE = 0;
constexpr size_t MISC_BTO = 16384;
constexpr size_t MISC_SGW = 65536;
constexpr size_t MISC_MEMN = 1 * MiB;
constexpr size_t MISC_KV = 3 * MiB;
constexpr size_t MISC_LIST = 5 * MiB;
constexpr size_t MISC_GW = 6 * MiB;
constexpr size_t MISC_RSC = 6 * MiB + 131072;
constexpr size_t MISC_SSQ = 7 * MiB;
constexpr size_t MISC_LSE = 8 * MiB;
constexpr size_t MISC_WRT = 10 * MiB;
constexpr size_t Z_QX = 0;
constexpr size_t Z_OX = 16 * MiB;
constexpr size_t Z_HID = 32 * MiB;
constexpr size_t Z_VN = 64 * MiB;
constexpr size_t Z_YS = 96 * MiB;
constexpr size_t W1E_SZ = (size_t)EVEN_IN * D, W2_SZ = (size_t)D * D, W1O_SZ = (size_t)ODD_IN * D, WQ_SZ = (size_t)512 * D, WKV_SZ = (size_t)1024 * D, WO_SZ = (size_t)D * 512;
constexpr size_t WO_W1E = 0, WO_W2E = WO_W1E + 2 * W1E_SZ, WO_W1O = WO_W2E + 2 * W2_SZ, WO_W2O = WO_W1O + 2 * W1O_SZ, WO_WQ = WO_W2O + 2 * W2_SZ, WO_WKV = WO_WQ + 4 * WQ_SZ, WO_WO = WO_WKV + 4 * WKV_SZ, WO_END = WO_WO + 4 * WO_SZ;
static_assert(WO_END * 2 <= 67 * MiB, "non-expert weights fit");
constexpr size_t WGU_SZ = (size_t)1024 * 1024, WD_SZ = (size_t)1024 * 512;
constexpr size_t WEX_WD = 16 * WGU_SZ;
constexpr int CW_CNT = 1024;
constexpr int CW_BAR = 8192;
constexpr int LDS_BYTES = 147456;
constexpr int LDS_BARW = 131072;
constexpr int LDS_MOE = 131072 + 64;

struct Params {
    const float *x, *mem, *ln_mix, *ln_cross, *ln_mem, *ln_ffn, *ln_final, *rel_table,
        *even_w_in, *even_w_out, *sgu_ln_g, *sgu_ln_b, *sgu_w, *sgu_b, *attn_sink,
        *odd_w_in, *odd_w_out, *xq_w, *xkv_w, *xo_w, *rgw, *rgb, *rew, *reb, *ewg, *ewu, *ewd;
    float* out;
    unsigned char* ws;
};

__device__ __forceinline__ int otid() { int t = threadIdx.x; asm volatile("" : "+v"(t)); return t; }
__device__ __forceinline__ int obid() { int t = blockIdx.x; asm volatile("" : "+s"(t)); return t; }
__device__ __forceinline__ float bf2f(bf16 b) { return __uint_as_float(((unsigned)b) << 16); }
__device__ __forceinline__ bf16 f2bf(float f) { unsigned u = __float_as_uint(f); u += 0x7fffu + ((u >> 16) & 1u); return (bf16)(u >> 16); }
__device__ __forceinline__ unsigned cvt_pk_bf16(float lo, float hi) { unsigned r; asm volatile("v_cvt_pk_bf16_f32 %0, %1, %2" : "=v"(r) : "v"(lo), "v"(hi)); return r; }
__device__ __forceinline__ float wave_sum(float v) {
#pragma unroll
    for (int o = 1; o < 64; o <<= 1) v += __shfl_xor(v, o);
    return v;
}
__device__ __forceinline__ float gelu_tanh(float x) {
    const float u2 = 1.5957691216057308f * (x + 0.044715f * x * x * x);
    return x * __builtin_amdgcn_rcpf(1.0f + __expf(-u2));
}
__device__ __forceinline__ int t5_bucket(int rel) {
    const int ret = rel > 0 ? 16 : 0;
    const int n = rel < 0 ? -rel : rel;
    if (n < 8) return ret + n;
    const float nf = (float)n;
    int large = 8 + (int)(logf(nf / 8.0f) / 4.852030263919617f * 8.0f);
    large = large < 15 ? large : 15;
    return ret + large;
}

#define XB_TMO      128
#define XB_XCNT(j)  (256  + 64 * (j))
#define XB_XSUB(j)  (1280 + 64 * (j))
#define XB_XGEN(j)  (2304 + 64 * (j))
#define XB_TOP      3328
#define XB_TOPGEN   3392
#define XCD_BAR_WORDS 3456
#define XB_SPIN_CAP (1u << 22)
__device__ __forceinline__ unsigned xb_ld(unsigned* p)              { return __hip_atomic_load(p, __ATOMIC_RELAXED, __HIP_MEMORY_SCOPE_AGENT); }
__device__ __forceinline__ unsigned xb_add(unsigned* p, unsigned v) { return __hip_atomic_fetch_add(p, v, __ATOMIC_RELAXED, __HIP_MEMORY_SCOPE_AGENT); }
__device__ __forceinline__ unsigned xb_xcc_id() { return (unsigned)__builtin_amdgcn_s_getreg((3 << 11) | 20) & 0xFu; }
#define XB_SPIN(cond, bar) do { unsigned _sp = 0; while (cond) { __builtin_amdgcn_s_sleep(1); \
    if ((++_sp & 255u) == 0u) { if (xb_ld(&(bar)[XB_TMO])) break; if (_sp > XB_SPIN_CAP) { atomicAdd(&(bar)[XB_TMO], 1u); break; } } } } while (0)
struct XcdBarrier { unsigned* bar; unsigned x; volatile LAS unsigned* st; };
__device__ __forceinline__ XcdBarrier xcd_barrier_post(unsigned* bar, volatile LAS unsigned* st) {
    XcdBarrier b; b.bar = bar; b.x = (unsigned)__builtin_amdgcn_readfirstlane((int)xb_xcc_id()); b.st = st;
    if (threadIdx.x == 0) (void)xb_add(&bar[XB_XCNT(b.x)], 1u);
    return b;
}
__device__ __forceinline__ void xcd_barrier_complete(unsigned* bar, unsigned x, unsigned& nloc, unsigned& nx) {
    const unsigned G = gridDim.x * gridDim.y * gridDim.z;
    unsigned sum, cnt, mine, sp = 0u;
    for (;;) {
        sum = 0u; cnt = 0u; mine = 0u;
#pragma unroll
        for (unsigned j = 0; j < 16; ++j) { const unsigned c = xb_ld(&bar[XB_XCNT(j)]); sum += c; cnt += (c > 0u) ? 1u : 0u; mine = (j == x) ? c : mine; }
        if (sum == G) break;
        __builtin_amdgcn_s_sleep(1);
        if ((++sp & 255u) == 0u) { if (xb_ld(&bar[XB_TMO])) break; if (sp > XB_SPIN_CAP) { atomicAdd(&bar[XB_TMO], 1u); break; } }
    }
    nloc = mine > 0u ? mine : 1u; nx = cnt > 0u ? cnt : 1u;
}
__device__ __forceinline__ void xcd_barrier(const XcdBarrier& b) {
    asm volatile("s_waitcnt vmcnt(0)" ::: "memory");
    __syncthreads();
    if (threadIdx.x == 0) {
        unsigned long long bzo = 0ull; unsigned bx = b.x; asm volatile("" : "+s"(bzo), "+s"(bx)); unsigned* bar = b.bar + bzo;
        __builtin_amdgcn_s_waitcnt(0);
        unsigned nloc = b.st[0], nx = b.st[1];
        if (nloc == 0u) { xcd_barrier_complete(bar, bx, nloc, nx); b.st[0] = nloc; b.st[1] = nx; }
        const unsigned old = xb_add(&bar[XB_XSUB(bx)], 1u);
        const unsigned gen = old / nloc;
        if (old + 1u == (gen + 1u) * nloc) {
            __builtin_amdgcn_fence(__ATOMIC_RELEASE, "agent");
            asm volatile("s_waitcnt vmcnt(0)" ::: "memory");
            const unsigned og = xb_add(&bar[XB_TOP], 1u);
            const unsigned tg = og / nx;
            if (og + 1u == (tg + 1u) * nx) xb_add(&bar[XB_TOPGEN], 1u);
            else XB_SPIN(xb_ld(&bar[XB_TOPGEN]) == tg, bar);
            __builtin_amdgcn_fence(__ATOMIC_ACQUIRE, "agent");
            xb_add(&bar[XB_XGEN(bx)], 1u);
            asm volatile("s_waitcnt vmcnt(0)" ::: "memory");
        } else {
            XB_SPIN(xb_ld(&bar[XB_XGEN(bx)]) == gen, bar);
            __builtin_amdgcn_fence(__ATOMIC_ACQUIRE, "agent");
            asm volatile("s_waitcnt vmcnt(0)" ::: "memory");
        }
    }
    __syncthreads();
}

namespace pg8 {
constexpr int BM = 256, BK = 64, HALF = 128, HTB = HALF * BK * 2, STAGE_BYTES = 8 * HTB, NXCD = 8, WGM = 8;
__host__ __device__ __forceinline__ int lds_byte(int r, int c) { const int st = (r >> 4) * 2 + (c >> 5), rr = r & 15, cc = c & 31, ob = rr * 64 + cc * 2; return st * 1024 + (ob ^ (((ob >> 9) & 1) << 5)); }
__host__ __device__ __forceinline__ void stage_rc(int b, int& R, int& C) { const int st = b / 1024, sb = b % 1024, swz = sb ^ (((sb >> 9) & 1) << 5); R = (st >> 1) * 16 + swz / 64; C = (st & 1) * 32 + (swz % 64) / 2; }
__host__ __device__ __forceinline__ int perm32(int rho) { const int n = rho >> 4, i = rho & 15; return 8 * (i >> 2) + 4 * n + (i & 3); }
struct Unit { int pm, pn, e, rows; };

struct DenseSched {
    int nM, nN, nwg, G, c, K; const bf16* Bt;
    __device__ void init(int M, int N, int K_, const bf16* Bt_, int G_, int c_) { nM = M / BM; nN = N / BM; nwg = nM * nN; G = G_; c = c_; K = K_; Bt = Bt_; }
    __device__ __forceinline__ bool next(int i, Unit& u) const {
        const long L = (long)i * G + c; if (L >= nwg) return false;
        int wgid = (int)L; { const int q = nwg / NXCD, r = nwg % NXCD, xcd = wgid % NXCD, off = wgid / NXCD; wgid = (xcd < r ? xcd * (q + 1) : r * (q + 1) + (xcd - r) * q) + off; }
        const int nig = WGM * nN, gid = wgid / nig, fm = gid * WGM, gsz = (nM - fm) < WGM ? (nM - fm) : WGM;
        u.pm = fm + ((wgid % nig) % gsz); u.pn = (wgid % nig) / gsz; u.e = 0; u.rows = 256; return true;
    }
    __device__ __forceinline__ unsigned arow(const Unit& u, int r) const { return (unsigned)(u.pm * BM + r) * (unsigned)(K * 2); }
    __device__ __forceinline__ const char* bbase(const Unit& u) const { return (const char*)Bt + (size_t)u.pn * BM * K * 2; }
};
template <bool TOKEN_ROWS>
struct MoeSched {
    int nN, G, c, K; const bf16* Bt; size_t bstride; const int* list; const LAS int* moe;
    __device__ __forceinline__ bool next(int i, Unit& u) const {
        const int L = i * G + c; const int total = moe[16] * nN; if (L >= total) return false;
        const int rt = L / nN; u.pn = L % nN; int e = 0;
#pragma unroll
        for (int j = 1; j < 16; ++j) e = (rt >= moe[j]) ? j : e;
        u.e = e; u.pm = rt - moe[e]; const int left = moe[17 + e] - u.pm * BM; u.rows = left < BM ? left : BM; return true;
    }
    __device__ __forceinline__ unsigned arow(const Unit& u, int r) const {
        const int idx = r < u.rows ? r : u.rows - 1; const int slot = list[u.e * LCAP + u.pm * BM + idx];
        return (unsigned)(TOKEN_ROWS ? (slot >> 1) : slot) * (unsigned)(K * 2);
    }
    __device__ __forceinline__ const char* bbase(const Unit& u) const { return (const char*)Bt + ((size_t)u.e * bstride + (size_t)u.pn * BM * K) * 2; }
};

template <class Epi, class Sched>
__device__ __forceinline__ void gemm_phase(LAS unsigned char* lds, const bf16* Abase, const int K, const Sched& S, const Epi& E) {
    const int tid = otid(), wid = __builtin_amdgcn_readfirstlane(tid >> 6), lane = tid & 63, wr = wid >> 2, wc = wid & 3, fr = lane & 15, fq = lane >> 4;
    const int nt = K / BK;
    unsigned voffB[2];
#pragma unroll
    for (int i = 0; i < 2; ++i) { int R, C; stage_rc(tid * 16 + i * 8192, R, C); const int Rb = Epi::PERM ? ((R & ~31) + perm32(R & 31)) : R;
        voffB[i] = (unsigned)(Rb * K + C) * 2u; }
#define PG8_AOFFS(u, o0, o1) do { const int _t = otid(); _Pragma("unroll") for (int _i = 0; _i < 2; ++_i) { int _R, _C; stage_rc(_t * 16 + _i * 8192, _R, _C); \
        o0[_i] = S.arow(u, _R) + (unsigned)_C * 2u; o1[_i] = S.arow(u, HALF + _R) + (unsigned)_C * 2u; } } while (0)
    const size_t kstep = (size_t)(BK * 2);
    const size_t hstep = (size_t)HALF * K * 2;
    const unsigned ldsw = (unsigned)wid * 1024u;
    const int aoff = lds_byte(wr * 64 + fr, fq * 8), boff = lds_byte(wc * 32 + fr, fq * 8);
    const char* Ab = (const char*)Abase;
#define PG8_SA(b, h) (((b) * 2 + (h)) * HTB)
#define PG8_SB(b, h) ((4 + (b) * 2 + (h)) * HTB)
#define PG8_STAGE(bufoff, gbase, voff) do { _Pragma("unroll") for (int _i = 0; _i < 2; ++_i) \
        __builtin_amdgcn_global_load_lds((const unsigned*)((const char*)(gbase) + (voff)[_i]), (LAS unsigned*)(lds + (bufoff) + ldsw + _i * 8192), 16, 0, 0); } while (0)
#define PG8_LDA(dst, b, h) do { _Pragma("unroll") for (int m = 0; m < 4; ++m) _Pragma("unroll") for (int k = 0; k < 2; ++k) dst[m][k] = *(const LAS bf16x8*)(lds + PG8_SA(b, h) + aoff + m * 2048 + k * 1024); } while (0)
#define PG8_LDB(dst, b, h) do { _Pragma("unroll") for (int n = 0; n < 2; ++n) _Pragma("unroll") for (int k = 0; k < 2; ++k) dst[n][k] = *(const LAS bf16x8*)(lds + PG8_SB(b, h) + boff + n * 2048 + k * 1024); } while (0)
#define PG8_MMA(ai, bj, At, Bt) do { __builtin_amdgcn_s_setprio(1); _Pragma("unroll") for (int m = 0; m < 4; ++m) _Pragma("unroll") for (int n = 0; n < 2; ++n) _Pragma("unroll") for (int k = 0; k < 2; ++k) \
        acc[ai][bj][m][n] = __builtin_amdgcn_mfma_f32_16x16x32_bf16(Bt[n][k], At[m][k], acc[ai][bj][m][n], 0, 0, 0); __builtin_amdgcn_s_setprio(0); } while (0)
#define PG8_WAIT_V(n) asm volatile("s_waitcnt vmcnt(" #n ")" ::: "memory")
#define PG8_WAIT_L(n) asm volatile("s_waitcnt lgkmcnt(" #n ")" ::: "memory")
#define PG8_BAR __builtin_amdgcn_s_barrier()
#define PG8_SCHED __builtin_amdgcn_sched_barrier(0)
    Unit cur, nxt; int ui = 0;
    if (!S.next(0, cur)) return;
    f32x4 acc[2][2][4][2];
#pragma unroll
    for (int a = 0; a < 2; ++a)
#pragma unroll
        for (int b = 0; b < 2; ++b)
#pragma unroll
            for (int m = 0; m < 4; ++m)
#pragma unroll
                for (int n = 0; n < 2; ++n) acc[a][b][m][n] = (f32x4){0.f, 0.f, 0.f, 0.f};
    bf16x8 At[4][2], B0[2][2], B1[2][2];
    unsigned oA0[2], oA1[2], oN0[2], oN1[2];
    PG8_AOFFS(cur, oA0, oA1);
    const char* cB = S.bbase(cur);
    PG8_STAGE(PG8_SB(0, 0), cB, voffB); PG8_STAGE(PG8_SB(0, 1), cB + hstep, voffB); PG8_STAGE(PG8_SA(0, 0), Ab, oA0); PG8_STAGE(PG8_SA(0, 1), Ab, oA1);
    if (wr == 1) PG8_BAR;
    PG8_WAIT_V(2); PG8_BAR;
    PG8_STAGE(PG8_SB(1, 0), cB + kstep, voffB); PG8_STAGE(PG8_SA(1, 0), Ab + kstep, oA0); PG8_STAGE(PG8_SB(1, 1), cB + hstep + kstep, voffB);
    PG8_WAIT_V(6); PG8_BAR;
    for (;;) {
        const bool has_next = S.next(ui + 1, nxt);
        const char* nB = has_next ? S.bbase(nxt) : cB;
        if (has_next) {
            PG8_AOFFS(nxt, oN0, oN1);
        } else {
#pragma unroll
            for (int i = 0; i < 2; ++i) { oN0[i] = oA0[i]; oN1[i] = oA1[i]; }
        }
        for (int t = 0; t < nt; t += 2) {
            const bool last = (t == nt - 2);
            const char* a1 = Ab + (size_t)(t + 1) * kstep;
            const char* a2 = last ? Ab : Ab + (size_t)(t + 2) * kstep; const char* b2 = last ? nB : cB + (size_t)(t + 2) * kstep;
            const char* a3 = a2 + kstep; const char* b3 = b2 + kstep;
            unsigned p0[2], p1[2];
#pragma unroll
            for (int i = 0; i < 2; ++i) { p0[i] = last ? oN0[i] : oA0[i]; p1[i] = last ? oN1[i] : oA1[i]; }
            PG8_LDB(B0, 0, 0); PG8_LDB(B1, 0, 1); PG8_SCHED; PG8_LDA(At, 0, 0); PG8_STAGE(PG8_SA(1, 1), a1, oA1);
            PG8_WAIT_V(8); PG8_WAIT_L(0); PG8_BAR; PG8_MMA(0, 0, At, B0); PG8_MMA(0, 1, At, B1); PG8_BAR; PG8_SCHED;
            PG8_LDA(At, 0, 1); PG8_STAGE(PG8_SB(0, 0), b2, voffB); PG8_STAGE(PG8_SB(0, 1), b2 + hstep, voffB); PG8_STAGE(PG8_SA(0, 0), a2, p0);
            PG8_WAIT_V(8); PG8_WAIT_L(0); PG8_BAR; PG8_MMA(1, 0, At, B0); PG8_MMA(1, 1, At, B1); PG8_BAR; PG8_SCHED;
            PG8_LDB(B0, 1, 0); PG8_LDB(B1, 1, 1); PG8_SCHED; PG8_LDA(At, 1, 0); PG8_STAGE(PG8_SA(0, 1), a2, p1);
            PG8_WAIT_V(8); PG8_WAIT_L(0); PG8_BAR; PG8_MMA(0, 0, At, B0); PG8_MMA(0, 1, At, B1); PG8_BAR; PG8_SCHED;
            PG8_LDA(At, 1, 1); PG8_STAGE(PG8_SB(1, 0), b3, voffB); PG8_STAGE(PG8_SB(1, 1), b3 + hstep, voffB); PG8_STAGE(PG8_SA(1, 0), a3, p0);
            PG8_WAIT_V(8); PG8_WAIT_L(0); PG8_BAR; PG8_MMA(1, 0, At, B0); PG8_MMA(1, 1, At, B1); PG8_BAR; PG8_SCHED;
        }
        if (wr == 0) PG8_BAR;
        E(acc, cur, wr, wc, fr, fq);
        if (!has_next) break;
#pragma unroll
        for (int a = 0; a < 2; ++a)
#pragma unroll
            for (int b = 0; b < 2; ++b)
#pragma unroll
                for (int m = 0; m < 4; ++m)
#pragma unroll
                    for (int n = 0; n < 2; ++n) acc[a][b][m][n] = (f32x4){0.f, 0.f, 0.f, 0.f};
        cur = nxt; cB = nB; ++ui;
#pragma unroll
        for (int i = 0; i < 2; ++i) { oA0[i] = oN0[i]; oA1[i] = oN1[i]; }
        if (wr == 1) PG8_BAR;
    }
    PG8_WAIT_V(0);
    PG8_BAR;
#undef PG8_AOFFS
#undef PG8_SA
#undef PG8_SB
#undef PG8_STAGE
#undef PG8_LDA
#undef PG8_LDB
#undef PG8_MMA
#undef PG8_WAIT_V
#undef PG8_WAIT_L
#undef PG8_BAR
#undef PG8_SCHED
}

__device__ __forceinline__ float row_rs(const float* ssqp, int row, int fq) {
    const f32x4 pp = *(const f32x4*)(ssqp + (size_t)row * 16 + 4 * fq);
    float s = (pp[0] + pp[1]) + (pp[2] + pp[3]);
    s += __shfl_xor(s, 16); s += __shfl_xor(s, 32);
    return rsqrtf(s * (1.0f / 1024.0f) + 1e-6f);
}
struct EpiScaleBf16 {
    static constexpr bool PERM = true;
    bf16* O; int ldc; const float* ssqp; int gelu_tiles;
    __device__ __forceinline__ void operator()(const f32x4 (&acc)[2][2][4][2], const Unit& u, int wr, int wc, int fr, int fq) const {
        const int row0 = u.pm * BM + wr * 64 + fr, col0 = u.pn * BM + wc * 32 + 8 * fq;
        const bool gl = u.pn < gelu_tiles;
#pragma unroll
        for (int ai = 0; ai < 2; ++ai)
#pragma unroll
            for (int m = 0; m < 4; ++m) {
                const int row = row0 + ai * HALF + m * 16;
                const float rs = ssqp ? row_rs(ssqp, row, fq) : 1.0f;
                bf16* rowp = O + (size_t)row * ldc + col0;
#pragma unroll
                for (int bj = 0; bj < 2; ++bj) {
                    f32x4 v0 = acc[ai][bj][m][0] * rs, v1 = acc[ai][bj][m][1] * rs;
                    if (gl) {
#pragma unroll
                        for (int j = 0; j < 4; ++j) { v0[j] = gelu_tanh(v0[j]); v1[j] = gelu_tanh(v1[j]); }
                    }
                    u32x4 w; w.x = cvt_pk_bf16(v0[0], v0[1]); w.y = cvt_pk_bf16(v0[2], v0[3]); w.z = cvt_pk_bf16(v1[0], v1[1]); w.w = cvt_pk_bf16(v1[2], v1[3]);
                    *(u32x4*)(rowp + bj * HALF) = w;
                }
            }
    }
};
template <bool BASE_F32>
struct EpiResidual {
    static constexpr bool PERM = false;
    const float* basef; bf16* hb; float* ssqp;
    __device__ __forceinline__ void operator()(const f32x4 (&acc)[2][2][4][2], const Unit& u, int wr, int wc, int fr, int fq) const {
        const int row0 = u.pm * BM + wr * 64 + fr, col0 = u.pn * BM + wc * 32 + 4 * fq;
#pragma unroll
        for (int ai = 0; ai < 2; ++ai)
#pragma unroll
            for (int m = 0; m < 4; ++m) {
                const int row = row0 + ai * HALF + m * 16; const size_t off = (size_t)row * D + col0; float ss = 0.f;
#pragma unroll
                for (int bj = 0; bj < 2; ++bj)
#pragma unroll
                    for (int n = 0; n < 2; ++n) {
                        f32x4 hv;
                        if constexpr (BASE_F32) hv = *(const f32x4*)(basef + off + bj * HALF + n * 16);
                        else { const u32x2 b = *(const u32x2*)(hb + off + bj * HALF + n * 16); hv = (f32x4){__uint_as_float(b.x << 16), __uint_as_float(b.x & 0xffff0000u), __uint_as_float(b.y << 16), __uint_as_float(b.y & 0xffff0000u)}; }
                        hv = hv + acc[ai][bj][m][n];
                        u32x2 w; w.x = cvt_pk_bf16(hv[0], hv[1]); w.y = cvt_pk_bf16(hv[2], hv[3]); *(u32x2*)(hb + off + bj * HALF + n * 16) = w;
                        ss += (hv[0] * hv[0] + hv[1] * hv[1]) + (hv[2] * hv[2] + hv[3] * hv[3]);
                    }
                ss += __shfl_xor(ss, 16); ss += __shfl_xor(ss, 32);
                if (fq == 0) ssqp[(size_t)row * 16 + u.pn * 4 + wc] = ss;
                asm volatile("" ::: "memory");
            }
    }
};
struct EpiMoe1 {
    static constexpr bool PERM = true;
    bf16* hid; const int* list; const float* rsc; const float* gatew;
    __device__ __forceinline__ void operator()(const f32x4 (&acc)[2][2][4][2], const Unit& u, int wr, int wc, int fr, int fq) const {
        const int f0 = u.pn * 128 + wc * 16 + 4 * fq;
#pragma unroll
        for (int ai = 0; ai < 2; ++ai)
#pragma unroll
            for (int m = 0; m < 4; ++m) {
                const int r = ai * HALF + wr * 64 + m * 16 + fr; const bool valid = r < u.rows;
                const int slot = list[u.e * LCAP + u.pm * BM + (valid ? r : u.rows - 1)];
                const float sc = rsc[slot], gw = gatew[slot];
#pragma unroll
                for (int bj = 0; bj < 2; ++bj) {
                    const f32x4 g = acc[ai][bj][m][0] * sc, up = acc[ai][bj][m][1] * sc; f32x4 o;
#pragma unroll
                    for (int j = 0; j < 4; ++j) o[j] = g[j] * __builtin_amdgcn_rcpf(1.0f + __expf(-g[j])) * up[j] * gw;
                    u32x2 w; w.x = cvt_pk_bf16(o[0], o[1]); w.y = cvt_pk_bf16(o[2], o[3]);
                    if (valid) *(u32x2*)(hid + (size_t)slot * 512 + f0 + bj * 64) = w;
                }
            }
    }
};
struct EpiMoe2 {
    static constexpr bool PERM = true;
    bf16* ys; const int* list;
    __device__ __forceinline__ void operator()(const f32x4 (&acc)[2][2][4][2], const Unit& u, int wr, int wc, int fr, int fq) const {
        const int col0 = u.pn * BM + wc * 32 + 8 * fq;
#pragma unroll
        for (int ai = 0; ai < 2; ++ai)
#pragma unroll
            for (int m = 0; m < 4; ++m) {
                const int r = ai * HALF + wr * 64 + m * 16 + fr; const bool valid = r < u.rows;
                const int slot = list[u.e * LCAP + u.pm * BM + (valid ? r : u.rows - 1)];
#pragma unroll
                for (int bj = 0; bj < 2; ++bj) {
                    const f32x4 v0 = acc[ai][bj][m][0], v1 = acc[ai][bj][m][1];
                    u32x4 w; w.x = cvt_pk_bf16(v0[0], v0[1]); w.y = cvt_pk_bf16(v0[2], v0[3]); w.z = cvt_pk_bf16(v1[0], v1[1]); w.w = cvt_pk_bf16(v1[2], v1[3]);
                    if (valid) *(u32x4*)(ys + (size_t)slot * D + col0 + bj * HALF) = w;
                }
            }
    }
};
}


namespace att {
constexpr int SHM_T = 16384;
constexpr int OFF_V = 0, OFF_K = 2 * SHM_T, OFF_WS = 4 * SHM_T, OFF_TAB = 4 * SHM_T + 4096;
#define ATT_KSWZ(row, colB) ((row) * 256 + ((colB) ^ (((row) & 7) << 4)))
__device__ __forceinline__ int crow(int r, int hi) { return (r & 3) + 8 * (r >> 2) + 4 * hi; }
__device__ __forceinline__ int v_st(int k, int c) { const int kk = (k & ~0xC) | ((k & 4) << 1) | ((k & 8) >> 1); return ((kk >> 3) * 4 + (c >> 5)) * 512 + ((kk & 7) * 32 + (c & 31)) * 2; }
__device__ __forceinline__ int v_rd_base(int lane) { return ((lane & 3) << 3) | (((lane >> 2) & 3) << 6) | (((lane >> 4) & 1) << 5) | (((lane >> 5) & 1) << 8); }
constexpr int v_rd_off(int d0, int ks, int half) { return d0 * 512 + ks * 4096 + half * 2048; }
typedef short s16x4 __attribute__((ext_vector_type(4)));
template <int OFF> __device__ __forceinline__ s16x4 tr_read(int vb) {
    s16x4 r; asm volatile("ds_read_b64_tr_b16 %0, %1 offset:%2" : "=&v"(r) : "v"(vb), "i"(OFF) : "memory"); return r;
}
template <int D0> __device__ __forceinline__ void pv_one(f32x16& od, int vb, bf16x8 pa0, bf16x8 pa1, bf16x8 pa2, bf16x8 pa3) {
    const s16x4 l0 = tr_read<v_rd_off(D0, 0, 0)>(vb), h0 = tr_read<v_rd_off(D0, 0, 1)>(vb), l1 = tr_read<v_rd_off(D0, 1, 0)>(vb), h1 = tr_read<v_rd_off(D0, 1, 1)>(vb);
    const s16x4 l2 = tr_read<v_rd_off(D0, 2, 0)>(vb), h2 = tr_read<v_rd_off(D0, 2, 1)>(vb), l3 = tr_read<v_rd_off(D0, 3, 0)>(vb), h3 = tr_read<v_rd_off(D0, 3, 1)>(vb);
    asm volatile("s_waitcnt lgkmcnt(0)" ::: "memory"); __builtin_amdgcn_sched_barrier(0);
#define ATT_PK(L, H) (bf16x8){L[0], L[1], L[2], L[3], H[0], H[1], H[2], H[3]}
    od = __builtin_amdgcn_mfma_f32_32x32x16_bf16(pa0, ATT_PK(l0, h0), od, 0, 0, 0);
    od = __builtin_amdgcn_mfma_f32_32x32x16_bf16(pa1, ATT_PK(l1, h1), od, 0, 0, 0);
    od = __builtin_amdgcn_mfma_f32_32x32x16_bf16(pa2, ATT_PK(l2, h2), od, 0, 0, 0);
    od = __builtin_amdgcn_mfma_f32_32x32x16_bf16(pa3, ATT_PK(l3, h3), od, 0, 0, 0);
#undef ATT_PK
}
template <int DK16, int DV32, bool MASK, int HALFWIN, class P>
__device__ __forceinline__ void attn_unit(LAS unsigned char* lds, const P& c, const int ntiles, const float C) {
    const int tid = otid(), wid = __builtin_amdgcn_readfirstlane(tid >> 6), lane = tid & 63, r32 = lane & 31, hi = lane >> 5;
    LAS unsigned char* V_lds = lds + OFF_V; LAS unsigned char* K_lds = lds + OFF_K;
    LAS float* wsf = (LAS float*)(lds + OFF_WS) + wid * 64; LAS float* li_l = wsf; LAS float* al_l = wsf + 32;
    bf16x8 qr[DK16];
    { const bf16* qp = c.q_ptr(wid, r32) + hi * 8;
#pragma unroll
      for (int d0 = 0; d0 < DK16; ++d0) qr[d0] = *(const bf16x8*)(qp + d0 * 16); }
    float m_reg = c.m0(wid), l_reg = c.l0(wid);
    f32x16 o[DV32];
#pragma unroll
    for (int d = 0; d < DV32; ++d)
#pragma unroll
        for (int r = 0; r < 16; ++r) o[d][r] = 0.f;
    constexpr bool D128 = (DK16 == 8);
    const int sr = D128 ? (tid >> 4) : (tid >> 3), sc = D128 ? (tid & 15) * 8 : (tid & 7) * 8;
    const int vst0 = v_st(sr, sc), vst1 = v_st(32 + sr, sc), kst0 = ATT_KSWZ(sr, sc * 2), kst1 = ATT_KSWZ(32 + sr, sc * 2);
    const int vb0 = (int)(unsigned)(uintptr_t)V_lds + v_rd_base(lane);
    bf16x8 ksA0, ksA1, vsA0, vsA1, ksB0, ksB1, vsB0, vsB1;
#define ATT_LOAD(X, t) do { const int _j = 64 * (t) + sr; ks##X##0 = *(const bf16x8*)(c.k_ptr(_j) + sc); vs##X##0 = *(const bf16x8*)(c.v_ptr(_j) + sc); \
        if (D128) { ks##X##1 = *(const bf16x8*)(c.k_ptr(_j + 32) + sc); vs##X##1 = *(const bf16x8*)(c.v_ptr(_j + 32) + sc); } } while (0)
#define ATT_WRITE(X, b) do { *(LAS bf16x8*)(V_lds + (b) * SHM_T + vst0) = vs##X##0; *(LAS bf16x8*)(K_lds + (b) * SHM_T + kst0) = ks##X##0; \
        if (D128) { *(LAS bf16x8*)(V_lds + (b) * SHM_T + vst1) = vs##X##1; *(LAS bf16x8*)(K_lds + (b) * SHM_T + kst1) = ks##X##1; } } while (0)
    auto compute = [&](const int t, const int b) __attribute__((always_inline)) {
        if (c.active(wid, t)) {
            f32x16 p0, p1;
#pragma unroll
            for (int r = 0; r < 16; ++r) { p0[r] = 0.f; p1[r] = 0.f; }
            const LAS unsigned char* Ks = K_lds + b * SHM_T;
#pragma unroll
            for (int d0 = 0; d0 < DK16; ++d0) { const int cb = (d0 * 16 + hi * 8) * 2;
                const bf16x8 b0 = *(const LAS bf16x8*)(Ks + ATT_KSWZ(r32, cb)); const bf16x8 b1 = *(const LAS bf16x8*)(Ks + ATT_KSWZ(32 + r32, cb));
                p0 = __builtin_amdgcn_mfma_f32_32x32x16_bf16(b0, qr[d0], p0, 0, 0, 0);
                p1 = __builtin_amdgcn_mfma_f32_32x32x16_bf16(b1, qr[d0], p1, 0, 0, 0); }
            if constexpr (MASK) {
                const int db = c.dbase(wid, r32, t) + 4 * hi, qi = c.qidx(wid, r32); const unsigned L = (unsigned)c.seqlen();
                const LAS float* tb = c.tab(wid) + (db + HALFWIN);
                float tv0[16], tv1[16];
#pragma unroll
                for (int r = 0; r < 16; ++r) { const int dc = (r & 3) + 8 * (r >> 2); tv0[r] = tb[dc]; tv1[r] = tb[dc + 32]; }
#pragma unroll
                for (int r = 0; r < 16; ++r) asm volatile("" : "+v"(tv0[r]), "+v"(tv1[r]));
#pragma unroll
                for (int r = 0; r < 16; ++r) { const int dc = (r & 3) + 8 * (r >> 2);
                    { const int d = db + dc; const bool ok = ((unsigned)(d + HALFWIN) <= (unsigned)(2 * HALFWIN)) & ((unsigned)(qi + d) < L);
                      p0[r] = ok ? fmaf(p0[r], C, tv0[r]) : -__builtin_inff(); }
                    { const int d = db + dc + 32; const bool ok = ((unsigned)(d + HALFWIN) <= (unsigned)(2 * HALFWIN)) & ((unsigned)(qi + d) < L);
                      p1[r] = ok ? fmaf(p1[r], C, tv1[r]) : -__builtin_inff(); } }
            } else {
#pragma unroll
                for (int r = 0; r < 16; ++r) { p0[r] *= C; p1[r] *= C; }
            }
            float pmax = p0[0];
#pragma unroll
            for (int r = 1; r < 16; ++r) pmax = fmaxf(pmax, p0[r]);
#pragma unroll
            for (int r = 0; r < 16; ++r) pmax = fmaxf(pmax, p1[r]);
            { auto rr = __builtin_amdgcn_permlane32_swap(__float_as_uint(pmax), __float_as_uint(pmax), false, false);
              pmax = fmaxf(__uint_as_float(rr[0]), __uint_as_float(rr[1])); }
            const float mn = fmaxf(m_reg, pmax), alpha = __builtin_amdgcn_exp2f(m_reg - mn); m_reg = mn;
            float ps = 0.f;
#pragma unroll
            for (int r = 0; r < 16; ++r) { p0[r] = __builtin_amdgcn_exp2f(p0[r] - mn); p1[r] = __builtin_amdgcn_exp2f(p1[r] - mn); ps += p0[r] + p1[r]; }
            { auto rr = __builtin_amdgcn_permlane32_swap(__float_as_uint(ps), __float_as_uint(ps), false, false);
              ps = __uint_as_float(rr[0]) + __uint_as_float(rr[1]); }
            l_reg = l_reg * alpha + ps;
            bf16x8 pa0, pa1, pa2, pa3;
#define ATT_PK4(Pv, BASE, OUT) do { const unsigned a0 = cvt_pk_bf16(Pv[BASE + 0], Pv[BASE + 1]), a1 = cvt_pk_bf16(Pv[BASE + 2], Pv[BASE + 3]); \
        const unsigned b0_ = cvt_pk_bf16(Pv[BASE + 4], Pv[BASE + 5]), b1_ = cvt_pk_bf16(Pv[BASE + 6], Pv[BASE + 7]); \
        auto r0 = __builtin_amdgcn_permlane32_swap(a0, b0_, false, false); auto r1 = __builtin_amdgcn_permlane32_swap(a1, b1_, false, false); \
        u32x4 w = {r0[0], r1[0], r0[1], r1[1]}; OUT = *reinterpret_cast<bf16x8*>(&w); } while (0)
            ATT_PK4(p0, 0, pa0); ATT_PK4(p0, 8, pa1); ATT_PK4(p1, 0, pa2); ATT_PK4(p1, 8, pa3);
#undef ATT_PK4
            if (__any(alpha < 1.f)) { if (hi == 0) al_l[r32] = alpha; asm volatile("s_waitcnt lgkmcnt(0)" ::: "memory");
#pragma unroll
                for (int r = 0; r < 16; ++r) { const float a = al_l[crow(r, hi)];
#pragma unroll
                    for (int d = 0; d < DV32; ++d) o[d][r] *= a; } }
            const int vb = vb0 + b * SHM_T;
            pv_one<0>(o[0], vb, pa0, pa1, pa2, pa3); pv_one<1>(o[1], vb, pa0, pa1, pa2, pa3);
            if constexpr (DV32 == 4) { pv_one<2>(o[2], vb, pa0, pa1, pa2, pa3); pv_one<3>(o[3], vb, pa0, pa1, pa2, pa3); }
        }
    };
    const int tl = ntiles - 1;
    ATT_LOAD(A, 0); ATT_WRITE(A, 0); ATT_LOAD(A, (1 < tl ? 1 : tl)); ATT_LOAD(B, (2 < tl ? 2 : tl));
    __syncthreads();
    for (int t = 0; t < ntiles; t += 2) {
        compute(t, 0); ATT_WRITE(A, 1); ATT_LOAD(A, (t + 3 < tl ? t + 3 : tl));
        __syncthreads();
        if (t + 1 >= ntiles) break;
        compute(t + 1, 1); ATT_WRITE(B, 0); ATT_LOAD(B, (t + 4 < tl ? t + 4 : tl));
        __syncthreads();
    }
#undef ATT_LOAD
#undef ATT_WRITE
    if (hi == 0) li_l[r32] = l_reg; asm volatile("s_waitcnt lgkmcnt(0)" ::: "memory");
    if (hi == 0) c.lse_store(wid, r32, (m_reg + __builtin_amdgcn_logf(l_reg)) * 0.6931471805599453f);
#pragma unroll
    for (int r = 0; r < 16; ++r) { const int orow = crow(r, hi); const float rl = __builtin_amdgcn_rcpf(li_l[orow]); bf16* op = c.out_ptr(wid, orow) + r32;
#pragma unroll
        for (int d = 0; d < DV32; ++d) op[d * 32] = f2bf(o[d][r] * rl); }
    asm volatile("s_waitcnt lgkmcnt(0)" ::: "memory");
}
#undef ATT_KSWZ

struct XattP {
    const bf16* qx; const bf16* kv; bf16* ox; int q0, h;
    __device__ __forceinline__ const bf16* q_ptr(int w, int r32) const { return qx + (size_t)(q0 + 32 * w + r32) * 512 + h * 128; }
    __device__ __forceinline__ const bf16* k_ptr(int j) const { return kv + (size_t)j * 1024 + h * 128; }
    __device__ __forceinline__ const bf16* v_ptr(int j) const { return kv + (size_t)j * 1024 + 512 + h * 128; }
    __device__ __forceinline__ bool active(int, int) const { return true; }
    __device__ __forceinline__ int dbase(int, int, int) const { return 0; }
    __device__ __forceinline__ int qidx(int, int) const { return 0; }
    __device__ __forceinline__ int seqlen() const { return 0; }
    __device__ __forceinline__ float m0(int) const { return -1e30f; }
    __device__ __forceinline__ float l0(int) const { return 0.f; }
    __device__ __forceinline__ const LAS float* tab(int) const { return nullptr; }
    __device__ __forceinline__ bf16* out_ptr(int w, int row) const { return ox + (size_t)(q0 + 32 * w + row) * 512 + h * 128; }
    __device__ __forceinline__ void lse_store(int, int, float) const {}
};
struct DattP {
    bf16* z; float* lse; const LAS float* tb; int g, h, dil, r, i0, L; bf16* zo;
    __device__ __forceinline__ size_t rowoff(int idx) const { return (size_t)(idx * dil + r) * ODD_IN + g * 3072 + h * 128; }
    __device__ __forceinline__ const bf16* q_ptr(int w, int r32) const { return z + rowoff(i0 + 32 * w + r32); }
    __device__ __forceinline__ int kidx(int j) const { int jj = i0 - 64 + j; jj = jj < 0 ? 0 : jj; return jj > L - 1 ? L - 1 : jj; }
    __device__ __forceinline__ const bf16* k_ptr(int j) const { return z + rowoff(kidx(j)) + 1024; }
    __device__ __forceinline__ const bf16* v_ptr(int j) const { return z + rowoff(kidx(j)) + 2048; }
    __device__ __forceinline__ bool active(int w, int t) const { return t >= (w >> 1) && t <= (w >> 1) + 2; }
    __device__ __forceinline__ int dbase(int w, int r32, int t) const { return 64 * t - 64 - 32 * w - r32; }
    __device__ __forceinline__ int qidx(int w, int r32) const { return i0 + 32 * w + r32; }
    __device__ __forceinline__ int seqlen() const { return L; }
    __device__ __forceinline__ float m0(int) const { return -1e30f; }
    __device__ __forceinline__ float l0(int) const { return 0.f; }
    __device__ __forceinline__ const LAS float* tab(int) const { return tb; }
    __device__ __forceinline__ bf16* out_ptr(int w, int row) const { return zo ? zo + (size_t)((i0 + 32 * w + row) * dil + r) * D + h * 128 : z + rowoff(i0 + 32 * w + row); }
    __device__ __forceinline__ void lse_store(int w, int row, float v) const { lse[((size_t)g * S + (size_t)(i0 + 32 * w + row) * dil + r) * 8 + h] = v; }
};
struct WattP {
    const bf16* z; bf16* y; const LAS float* tb; const float* sink; int kv, q0;
    __device__ __forceinline__ const bf16* q_ptr(int w, int r32) const { return z + (size_t)(q0 + 32 * (w >> 2) + r32) * EVEN_IN + 1024 + (kv * 4 + (w & 3)) * 64; }
    __device__ __forceinline__ int kpos(int j) const { int jj = q0 - 128 + j; jj = jj < 0 ? 0 : jj; return jj > S - 1 ? S - 1 : jj; }
    __device__ __forceinline__ const bf16* k_ptr(int j) const { return z + (size_t)kpos(j) * EVEN_IN + 1536 + kv * 64; }
    __device__ __forceinline__ const bf16* v_ptr(int j) const { return z + (size_t)kpos(j) * EVEN_IN + 1664 + kv * 64; }
    __device__ __forceinline__ bool active(int, int) const { return true; }
    __device__ __forceinline__ int dbase(int w, int r32, int t) const { return 64 * t - 128 - 32 * (w >> 2) - r32; }
    __device__ __forceinline__ int qidx(int w, int r32) const { return q0 + 32 * (w >> 2) + r32; }
    __device__ __forceinline__ int seqlen() const { return S; }
    __device__ __forceinline__ float m0(int w) const { return sink[kv * 4 + (w & 3)] * 1.4426950408889634f; }
    __device__ __forceinline__ float l0(int) const { return 1.f; }
    __device__ __forceinline__ const LAS float* tab(int w) const { return tb + (w & 3) * 257; }
    __device__ __forceinline__ bf16* out_ptr(int w, int row) const { return y + (size_t)(q0 + 32 * (w >> 2) + row) * D + 512 + (kv * 4 + (w & 3)) * 64; }
    __device__ __forceinline__ void lse_store(int, int, float) const {}
};
}

template <class RM>
__device__ __forceinline__ void cvt_item(const float* W, int N, int K, const float* g, bf16* WT, RM rowmap, LAS float* scr, int kb, int nb, int lane) {
    const int k0 = 64 * kb, n0 = 32 * nb;
    float v[32];
#pragma unroll
    for (int i = 0; i < 32; ++i) { const int kk = 2 * i + (lane >> 5); v[i] = W[(size_t)(k0 + kk) * N + n0 + (lane & 31)]; }
    if (g) {
#pragma unroll
        for (int i = 0; i < 32; ++i) v[i] *= g[k0 + 2 * i + (lane >> 5)];
    }
#pragma unroll
    for (int i = 0; i < 32; ++i) { const int kk = 2 * i + (lane >> 5); scr[kk * 33 + (lane & 31)] = v[i]; }
    asm volatile("s_waitcnt lgkmcnt(0)" ::: "memory");
    const int c = lane & 7;
#pragma unroll
    for (int j = 0; j < 4; ++j) { const int n = (lane >> 3) + 8 * j; const LAS float* s = scr + (8 * c) * 33 + n;
        u32x4 o; o.x = cvt_pk_bf16(s[0 * 33], s[1 * 33]); o.y = cvt_pk_bf16(s[2 * 33], s[3 * 33]); o.z = cvt_pk_bf16(s[4 * 33], s[5 * 33]); o.w = cvt_pk_bf16(s[6 * 33], s[7 * 33]);
        *(u32x4*)(WT + (size_t)rowmap(n0 + n) * K + k0 + 8 * c) = o; }
    asm volatile("s_waitcnt lgkmcnt(0)" ::: "memory");
}
struct CvtCtx { int gw, NGW, base, lane; LAS float* scr; };
template <class RM>
__device__ __forceinline__ void cvt_matrix(CvtCtx& c, const float* W, int K, int N, const float* g, bf16* WT, RM rowmap) {
    const int nblk = N / 32, nitems = (K / 64) * nblk;
    int j0 = (c.gw - c.base) % c.NGW; if (j0 < 0) j0 += c.NGW;
    for (int j = j0; j < nitems; j += c.NGW) cvt_item(W, N, K, g, WT, rowmap, c.scr, j / nblk, j % nblk, c.lane);
    c.base = (c.base + nitems) % c.NGW;
}

__device__ __forceinline__ void rms_row_bf16(const float4 (&v)[4], float rs, const float* g, bf16* dst, int lane) {
#pragma unroll
    for (int j = 0; j < 4; ++j) { const float4 gg = g ? ((const float4*)g)[lane + 64 * j] : make_float4(1.f, 1.f, 1.f, 1.f);
        u32x2 w; w.x = cvt_pk_bf16(v[j].x * rs * gg.x, v[j].y * rs * gg.y); w.y = cvt_pk_bf16(v[j].z * rs * gg.z, v[j].w * rs * gg.w); ((u32x2*)dst)[lane + 64 * j] = w; }
}

enum Phase { PH_INIT = 0, PH_EXPCVT, PH_GEMM1, PH_SGU, PH_WATT, PH_DATT, PH_COMB, PH_GEMM2, PH_GEMM3, PH_XATT, PH_GEMM4, PH_ROUTE, PH_MOE1, PH_MOE2, PH_FIN };

#define GAS __attribute__((address_space(1)))
#define CAS __attribute__((address_space(4)))
template <class T> __device__ __forceinline__ T* as_global(T* q) { return (T*)(GAS T*)q; }
template <int PH, bool PRB = false>
__device__ __forceinline__ void run_phase(int layer, LAS unsigned char* lds) {
    unsigned long long wzo = 0ull;
    asm volatile("" : "+s"(wzo), "+s"(layer));
    const CAS Params* pk = (const CAS Params*)((const CAS char*)__builtin_amdgcn_kernarg_segment_ptr() + wzo);
    Params p;
#define LDP(f) p.f = as_global(pk->f)
    LDP(x); LDP(mem); LDP(ln_mix); LDP(ln_cross); LDP(ln_mem); LDP(ln_ffn); LDP(ln_final); LDP(rel_table); LDP(even_w_in); LDP(even_w_out); LDP(sgu_ln_g); LDP(sgu_ln_b); LDP(sgu_w); LDP(sgu_b); LDP(attn_sink);
    LDP(odd_w_in); LDP(odd_w_out); LDP(xq_w); LDP(xkv_w); LDP(xo_w); LDP(rgw); LDP(rgb); LDP(rew); LDP(reb); LDP(ewg); LDP(ewu); LDP(ewd); LDP(out); LDP(ws);
#undef LDP
    unsigned char* ws = p.ws;
    float* h = (float*)(ws + WS_H); bf16* hb = (bf16*)(ws + WS_HB); bf16* y = (bf16*)(ws + WS_Y); bf16* z = (bf16*)(ws + WS_Z);
    bf16* wnx = (bf16*)(ws + WS_WNX); bf16* wex = (bf16*)(ws + WS_WEX);
    float* bte = (float*)(ws + WS_MISC + MISC_BTE); float* bto = (float*)(ws + WS_MISC + MISC_BTO);
    bf16* memn = (bf16*)(ws + WS_MISC + MISC_MEMN); bf16* kvm = (bf16*)(ws + WS_MISC + MISC_KV);
    int* lists = (int*)(ws + WS_MISC + MISC_LIST); float* gatew = (float*)(ws + WS_MISC + MISC_GW); float* rsc = (float*)(ws + WS_MISC + MISC_RSC);
    float* ssqp = (float*)(ws + WS_MISC + MISC_SSQ);
    bf16* qx = (bf16*)(ws + WS_Z + Z_QX); bf16* ox = (bf16*)(ws + WS_Z + Z_OX); bf16* hid = (bf16*)(ws + WS_Z + Z_HID); bf16* ys = (bf16*)(ws + WS_Z + Z_YS); float* vn = (float*)(ws + WS_Z + Z_VN);
    unsigned* ctl = (unsigned*)(ws + WS_CTL);
    const int tid = otid(), lane = tid & 63, wv = tid >> 6; const int bid = obid();
    const int gtid = bid * NT + tid, GT = gridDim.x * NT;
    const int gw = bid * (NT / 64) + wv, NGW = gridDim.x * (NT / 64);
    const int il = layer >> 1;
    const bool even = (layer & 1) == 0;
    const int G = gridDim.x;

    if constexpr (PH == PH_INIT) {
        for (int i = gtid; i < 8 * 257; i += GT) { const int hh = i / 257, rel = i % 257 - 128; bte[i] = p.rel_table[t5_bucket(rel) * 8 + hh]; }
        for (int i = gtid; i < 3 * 8 * 129; i += GT) { const int g = i / (8 * 129), hh = (i / 129) % 8, j = i % 129 - 64; const int dil = g == 0 ? 1 : (g == 1 ? 4 : 16); bto[i] = p.rel_table[t5_bucket(j * dil) * 8 + hh]; }
        { bf16* sgwd = (bf16*)(ws + WS_MISC + MISC_SGW); for (int i = gtid; i < 2 * 4 * 128 * 128; i += GT) sgwd[i] = f2bf(p.sgu_w[i]); }
        {
            bf16* wrt = (bf16*)(ws + WS_MISC + MISC_WRT);
            for (int i = gtid; i < DEPTH * 32 * 1024; i += GT) { const int l = i >> 15, c = (i >> 10) & 31, k = i & 1023; const float gk = p.ln_ffn[l * D + k];
                wrt[i] = c < 4 ? f2bf(gk * p.rgw[((size_t)l * D + k) * 4 + c]) : (c < 20 ? f2bf(gk * p.rew[((size_t)l * D + k) * 16 + (c - 4)]) : (bf16)0); }
        }
        for (int r = gw; r < S; r += NGW) {
            const float4* s4 = (const float4*)(p.x + (size_t)r * D); float4 v[4]; float ss = 0.f;
#pragma unroll
            for (int j = 0; j < 4; ++j) { v[j] = s4[lane + 64 * j]; ss += v[j].x * v[j].x + v[j].y * v[j].y + v[j].z * v[j].z + v[j].w * v[j].w; }
            ss = wave_sum(ss);
            rms_row_bf16(v, 1.0f, nullptr, hb + (size_t)r * D, lane);
            if (lane < 16) ssqp[(size_t)r * 16 + lane] = lane == 0 ? ss : 0.f;
        }
        for (int r = gw; r < MEM; r += NGW) {
            const float4* s4 = (const float4*)(p.mem + (size_t)r * D); float4 v[4]; float ss = 0.f;
#pragma unroll
            for (int j = 0; j < 4; ++j) { v[j] = s4[lane + 64 * j]; ss += v[j].x * v[j].x + v[j].y * v[j].y + v[j].z * v[j].z + v[j].w * v[j].w; }
            const float rs = rsqrtf(wave_sum(ss) * (1.0f / D) + 1e-6f);
            for (int l = 0; l < DEPTH; ++l) rms_row_bf16(v, rs, p.ln_mem + l * D, memn + ((size_t)l * MEM + r) * D, lane);
        }
        CvtCtx c{gw, NGW, 0, lane, (LAS float*)(lds + wv * 16384)};
        auto idm = [](int n) { return n; };
        for (int i = 0; i < 2; ++i) {
            cvt_matrix(c, p.even_w_in + (size_t)i * D * EVEN_IN, D, EVEN_IN, p.ln_mix + (2 * i) * D, wnx + WO_W1E + i * W1E_SZ, idm);
            cvt_matrix(c, p.even_w_out + (size_t)i * D * D, D, D, nullptr, wnx + WO_W2E + i * W2_SZ, idm);
            cvt_matrix(c, p.odd_w_in + (size_t)i * D * ODD_IN, D, ODD_IN, p.ln_mix + (2 * i + 1) * D, wnx + WO_W1O + i * W1O_SZ, idm);
            cvt_matrix(c, p.odd_w_out + (size_t)i * D * D, D, D, nullptr, wnx + WO_W2O + i * W2_SZ, idm);
        }
        for (int l = 0; l < DEPTH; ++l) {
            cvt_matrix(c, p.xq_w + (size_t)l * D * 512, D, 512, p.ln_cross + l * D, wnx + WO_WQ + l * WQ_SZ, idm);
            cvt_matrix(c, p.xkv_w + (size_t)l * D * 1024, D, 1024, nullptr, wnx + WO_WKV + l * WKV_SZ, idm);
            cvt_matrix(c, p.xo_w + (size_t)l * 512 * D, 512, D, nullptr, wnx + WO_WO + l * WO_SZ, idm);
        }
    }
    if constexpr (PH == PH_EXPCVT || PH == PH_GEMM3) if (PH == PH_EXPCVT || bid >= 128) {
        const int cb0 = (PH == PH_GEMM3) ? 128 : 0;
        CvtCtx c{(bid - cb0) * (NT / 64) + wv, (G - cb0) * (NT / 64), 0, lane, (LAS float*)(lds + wv * 16384)};
        const float* gf = p.ln_ffn + layer * D;
        for (int e = 0; e < 16; ++e) {
            cvt_matrix(c, p.ewg + ((size_t)layer * 16 + e) * D * 512, D, 512, gf, wex + e * WGU_SZ, [](int n) { return 8 * (n >> 2) + (n & 3); });
            cvt_matrix(c, p.ewu + ((size_t)layer * 16 + e) * D * 512, D, 512, gf, wex + e * WGU_SZ, [](int n) { return 8 * (n >> 2) + 4 + (n & 3); });
            cvt_matrix(c, p.ewd + ((size_t)layer * 16 + e) * 512 * D, 512, D, nullptr, wex + WEX_WD + e * WD_SZ, [](int n) { return n; });
        }
    }
    if constexpr (PH == PH_GEMM1) {
        const int N = even ? EVEN_IN : ODD_IN;
        const bf16* W = even ? wnx + WO_W1E + il * W1E_SZ : wnx + WO_W1O + il * W1O_SZ;
        pg8::DenseSched Sd; Sd.init(S, N, D, W, G, bid);
        pg8::EpiScaleBf16 E{z, N, ssqp, even ? 4 : 0};
        pg8::gemm_phase(lds, hb, D, Sd, E);
        if (layer == 0 && bid >= G - 16) {
            const int uidx = bid - (G - 16), l = uidx >> 2;
            pg8::DenseSched Sk; Sk.init(MEM, 1024, D, wnx + WO_WKV + l * WKV_SZ, 4, uidx & 3);
            pg8::EpiScaleBf16 Ek{kvm + (size_t)l * MEM * 1024, 1024, nullptr, 0};
            pg8::gemm_phase(lds, memn + (size_t)l * MEM * D, D, Sk, Ek);
        }
    }
    if constexpr (PH == PH_SGU) {
        const bf16* sgw = (const bf16*)(ws + WS_MISC + MISC_SGW) + (size_t)il * 4 * 128 * 128;
        const float* lg = p.sgu_ln_g + il * 512; const float* lb = p.sgu_ln_b + il * 512; const float* bs = p.sgu_b + il * 512;
        LAS unsigned char* vnt = lds + 77824;
        LAS float* st = (LAS float*)(lds + 77824 + 34816);
        const int wid = __builtin_amdgcn_readfirstlane(tid >> 6), r32 = lane & 31, hi = lane >> 5;
        for (int u = bid; u < 512; u += G) {
            const int g = u & 3, t0 = (u >> 2) * 128;
            {
                const int q = tid >> 2, part = tid & 3; const bf16* vp = z + (size_t)(t0 + q) * EVEN_IN + 512 + part * 128; float s = 0.f, s2 = 0.f;
#pragma unroll
                for (int i = 0; i < 16; ++i) { const u32x4 w = *(const u32x4*)(vp + 8 * i);
#pragma unroll
                    for (int k = 0; k < 4; ++k) { const float a = __uint_as_float(w[k] << 16), b = __uint_as_float(w[k] & 0xffff0000u); s += a + b; s2 += a * a + b * b; } }
                s += __shfl_xor(s, 1); s += __shfl_xor(s, 2); s2 += __shfl_xor(s2, 1); s2 += __shfl_xor(s2, 2);
                const float mu = s * (1.f / 512.f), var = s2 * (1.f / 512.f) - mu * mu;
                if (part == 0) { st[2 * q] = mu; st[2 * q + 1] = rsqrtf(fmaxf(var, 0.f) + 1e-6f); }
            }
            __syncthreads();
#pragma unroll
            for (int it = 0; it < 4; ++it) {
                const int item = tid + NT * it, q = item & 127, cc = item >> 7;
                const u32x4 w = *(const u32x4*)(z + (size_t)(t0 + q) * EVEN_IN + 512 + g * 128 + 8 * cc); const float mu = st[2 * q], rstd = st[2 * q + 1];
#pragma unroll
                for (int k = 0; k < 8; ++k) { const int c = 8 * cc + k; const float v = (k & 1) ? __uint_as_float(w[k >> 1] & 0xffff0000u) : __uint_as_float(w[k >> 1] << 16);
                    *(LAS bf16*)(vnt + c * 272 + q * 2) = f2bf((v - mu) * rstd * lg[g * 128 + c] + lb[g * 128 + c]); }
            }
            __syncthreads();
            const int pb = wid >> 1, cb0 = (wid & 1) * 2;
            bf16x8 af[8];
#pragma unroll
            for (int ks = 0; ks < 8; ++ks) af[ks] = *(const bf16x8*)(sgw + (size_t)(g * 128 + 32 * pb + r32) * 128 + 16 * ks + 8 * hi);
            f32x16 acc0, acc1;
#pragma unroll
            for (int r = 0; r < 16; ++r) { acc0[r] = 0.f; acc1[r] = 0.f; }
#pragma unroll
            for (int ks = 0; ks < 8; ++ks) {
                const bf16x8 b0 = *(const LAS bf16x8*)(vnt + (32 * cb0 + r32) * 272 + (16 * ks + 8 * hi) * 2);
                const bf16x8 b1 = *(const LAS bf16x8*)(vnt + (32 * (cb0 + 1) + r32) * 272 + (16 * ks + 8 * hi) * 2);
                acc0 = __builtin_amdgcn_mfma_f32_32x32x16_bf16(af[ks], b0, acc0, 0, 0, 0);
                acc1 = __builtin_amdgcn_mfma_f32_32x32x16_bf16(af[ks], b1, acc1, 0, 0, 0);
            }
#pragma unroll
            for (int r = 0; r < 16; ++r) {
                const int prow = 32 * pb + att::crow(r, hi), tok = t0 + prow; const float bias = bs[g * 128 + prow];
                const int col = g * 128 + 32 * cb0 + r32;
                y[(size_t)tok * D + col] = f2bf(bf2f(z[(size_t)tok * EVEN_IN + col]) * (acc0[r] + bias));
                y[(size_t)tok * D + col + 32] = f2bf(bf2f(z[(size_t)tok * EVEN_IN + col + 32]) * (acc1[r] + bias));
            }
            __syncthreads();
        }
    }
    if constexpr (PH == PH_WATT) {
        LAS float* tb = (LAS float*)(lds + att::OFF_TAB);
        for (int u = bid; u < (S / 64) * 2; u += G) {
            const int kv = u & 1, blk = u >> 1;
            for (int i = tid; i < 4 * 257; i += NT) tb[i] = bte[(kv * 4 + i / 257) * 257 + i % 257] * 1.4426950408889634f;
            att::WattP P{z, y, tb, p.attn_sink + il * 8, kv, blk * 64};
            att::attn_unit<4, 2, true, 128>(lds, P, 5, 0.125f * 1.4426950408889634f);
        }
    }
    if constexpr (PH == PH_DATT) {
        float* lse = (float*)(ws + WS_MISC + MISC_LSE);
        LAS float* tb = (LAS float*)(lds + att::OFF_TAB);
        for (int u = bid; u < 3 * 512; u += G) {
            const int g = u >> 9, uu = u & 511, hh = uu & 7, rest = uu >> 3;
            const int dil = g == 0 ? 1 : (g == 1 ? 4 : 16), r = rest % dil, blk = rest / dil;
            if (tid < 129) tb[tid] = bto[(g * 8 + hh) * 129 + tid] * 1.4426950408889634f;
            att::DattP P{z, PRB ? (float*)hb : lse, tb, g, hh, dil, r, blk * 256, S / dil, PRB ? y : nullptr};
            att::attn_unit<8, 4, true, 64>(lds, P, 6, 0.08838834764831845f * 1.4426950408889634f);
        }
    }
    if constexpr (PH == PH_COMB) {
        const float* lse = (const float*)(ws + WS_MISC + MISC_LSE);
        for (int i = gtid; i < S * 128; i += GT) {
            const int pos = i >> 7, ch = i & 127, hh = ch >> 4;
            const float l0 = lse[((size_t)0 * S + pos) * 8 + hh], l1 = lse[((size_t)1 * S + pos) * 8 + hh], l2 = lse[((size_t)2 * S + pos) * 8 + hh];
            const float mx = fmaxf(l0, fmaxf(l1, l2)); float w0 = __expf(l0 - mx), w1 = __expf(l1 - mx), w2 = __expf(l2 - mx); const float inv = 1.0f / (w0 + w1 + w2); w0 *= inv; w1 *= inv; w2 *= inv;
            const bf16* zr = z + (size_t)pos * ODD_IN + ch * 8;
            const u32x4 a = *(const u32x4*)zr, b = *(const u32x4*)(zr + 3072), c = *(const u32x4*)(zr + 6144); u32x4 o;
#pragma unroll
            for (int k = 0; k < 4; ++k) {
                const float lo = w0 * __uint_as_float(a[k] << 16) + w1 * __uint_as_float(b[k] << 16) + w2 * __uint_as_float(c[k] << 16);
                const float hi2 = w0 * __uint_as_float(a[k] & 0xffff0000u) + w1 * __uint_as_float(b[k] & 0xffff0000u) + w2 * __uint_as_float(c[k] & 0xffff0000u);
                o[k] = cvt_pk_bf16(lo, hi2); }
            *(u32x4*)(y + (size_t)pos * D + ch * 8) = o;
        }
    }
    if constexpr (PH == PH_GEMM2) {
        const bf16* W = even ? wnx + WO_W2E + il * W2_SZ : wnx + WO_W2O + il * W2_SZ;
        pg8::DenseSched Sd; Sd.init(S, D, D, W, G, bid);
        if (layer == 0) { pg8::EpiResidual<true> E{p.x, hb, ssqp}; pg8::gemm_phase(lds, y, D, Sd, E); }
        else { pg8::EpiResidual<false> E{nullptr, hb, ssqp}; pg8::gemm_phase(lds, y, D, Sd, E); }
    }
    if constexpr (PH == PH_GEMM3) if (bid < 128) {
        pg8::DenseSched Sd; Sd.init(S, 512, D, wnx + WO_WQ + layer * WQ_SZ, 128, bid);
        pg8::EpiScaleBf16 E{qx, 512, ssqp, 0};
        pg8::gemm_phase(lds, hb, D, Sd, E);
    }
    if constexpr (PH == PH_XATT) {
        const bf16* kvl = kvm + (size_t)layer * MEM * 1024;
        for (int u = bid; u < (S / 256) * 4; u += G) {
            att::XattP P{qx, kvl, ox, (u >> 2) * 256, u & 3};
            att::attn_unit<8, 4, false, 64>(lds, P, 4, 0.08838834764831845f * 1.4426950408889634f);
        }
    }
    if constexpr (PH == PH_GEMM4) {
        pg8::DenseSched Sd; Sd.init(S, D, 512, wnx + WO_WO + layer * WO_SZ, G, bid);
        pg8::EpiResidual<false> E{nullptr, hb, ssqp};
        pg8::gemm_phase(lds, ox, 512, Sd, E);
    }
    if constexpr (PH == PH_ROUTE) {
        const bf16* wrt = (const bf16*)(ws + WS_MISC + MISC_WRT) + (size_t)layer * 32 * 1024;
        const float* bg = p.rgb + layer * 4; const float* be = p.reb + layer * 16;
        unsigned* cn = ctl + (PRB ? 65536 : CW_CNT); int* ls = PRB ? (int*)(ws + WS_Z + 160 * MiB) : lists; float* gwp = PRB ? (float*)(ws + WS_Z + 162 * MiB) : gatew; float* rsp = PRB ? (float*)(ws + WS_Z + 163 * MiB) : rsc;
        LAS float* lgt = (LAS float*)lds;
        LAS unsigned* lcnt = (LAS unsigned*)(lds + 16384);
        const int wid = __builtin_amdgcn_readfirstlane(tid >> 6), tg = wid >> 1, cb = wid & 1, l15 = lane & 15, kg = lane >> 4;
        for (int u = bid; u < S / 64; u += G) {
            const int t0 = u * 64;
            if (tid < 32) lcnt[tid] = 0u;
            f32x4 acc = (f32x4){0.f, 0.f, 0.f, 0.f};
            const bf16* ap = hb + (size_t)(t0 + 16 * tg + l15) * D + 8 * kg; const bf16* bp = wrt + (size_t)(16 * cb + l15) * 1024 + 8 * kg;
#pragma unroll 8
            for (int s = 0; s < 32; ++s) { const bf16x8 a = *(const bf16x8*)(ap + 32 * s), b = *(const bf16x8*)(bp + 32 * s); acc = __builtin_amdgcn_mfma_f32_16x16x32_bf16(a, b, acc, 0, 0, 0); }
#pragma unroll
            for (int r = 0; r < 4; ++r) lgt[(16 * tg + 4 * kg + r) * 33 + 16 * cb + l15] = acc[r];
            __syncthreads();
            int E0 = 0, E1 = 0; unsigned lp0 = 0, lp1 = 0; float g0 = 0.f, g1 = 0.f, rs = 0.f;
            if (tid < 64) {
                const int t = t0 + tid; float ssq = 0.f;
#pragma unroll
                for (int j = 0; j < 4; ++j) { const f32x4 q = *(const f32x4*)(ssqp + (size_t)t * 16 + 4 * j); ssq += (q[0] + q[1]) + (q[2] + q[3]); }
                rs = rsqrtf(ssq * (1.0f / D) + 1e-6f);
                float lg[4], le[16];
#pragma unroll
                for (int c = 0; c < 4; ++c) lg[c] = lgt[tid * 33 + c] * rs + bg[c];
#pragma unroll
                for (int c = 0; c < 16; ++c) le[c] = lgt[tid * 33 + 4 + c] * rs + be[c];
                int grp = 0; float gm = lg[0];
#pragma unroll
                for (int c = 1; c < 4; ++c) if (lg[c] > gm) { gm = lg[c]; grp = c; }
                float gs = 0.f;
#pragma unroll
                for (int c = 0; c < 4; ++c) gs += __expf(lg[c] - gm);
                const float ggate = 1.0f / gs;
                float es[4];
#pragma unroll
                for (int e = 0; e < 4; ++e) es[e] = grp == 0 ? le[e] : (grp == 1 ? le[4 + e] : (grp == 2 ? le[8 + e] : le[12 + e]));
                int i0 = 0; float v0 = es[0];
#pragma unroll
                for (int e = 1; e < 4; ++e) if (es[e] > v0) { v0 = es[e]; i0 = e; }
                int i1 = -1; float v1 = -3.0e38f;
#pragma unroll
                for (int e = 0; e < 4; ++e) if (e != i0 && es[e] > v1) { v1 = es[e]; i1 = e; }
                const float ex = __expf(v1 - v0); g0 = ggate / (1.0f + ex); g1 = ggate * ex / (1.0f + ex);
                E0 = grp * 4 + i0; E1 = grp * 4 + i1;
                lp0 = __hip_atomic_fetch_add(lcnt + E0, 1u, __ATOMIC_RELAXED, __HIP_MEMORY_SCOPE_WORKGROUP);
                lp1 = __hip_atomic_fetch_add(lcnt + E1, 1u, __ATOMIC_RELAXED, __HIP_MEMORY_SCOPE_WORKGROUP);
            }
            __syncthreads();
            if (tid < 16) { const unsigned c = lcnt[tid]; lcnt[16 + tid] = c ? atomicAdd(&cn[(layer * 16 + tid) * 64], c) : 0u; }
            __syncthreads();
            if (tid < 64) {
                const int t = t0 + tid;
                ls[E0 * LCAP + lcnt[16 + E0] + lp0] = 2 * t; ls[E1 * LCAP + lcnt[16 + E1] + lp1] = 2 * t + 1;
                gwp[2 * t] = g0; gwp[2 * t + 1] = g1; rsp[2 * t] = rs; rsp[2 * t + 1] = rs;
            }
            __syncthreads();
        }
    }
    if constexpr (PH == PH_MOE1 || PH == PH_MOE2) {
        LAS int* moe = (LAS int*)(lds + LDS_MOE);
        if (tid == 0) { int acc = 0; for (int e = 0; e < 16; ++e) { const int c = (int)ctl[CW_CNT + (layer * 16 + e) * 64]; moe[e] = acc; moe[17 + e] = c; acc += (c + 255) >> 8; } moe[16] = acc; }
        __syncthreads();
        if constexpr (PH == PH_MOE1) {
            pg8::MoeSched<true> Sm{4, G, bid, D, wex, WGU_SZ, lists, moe};
            pg8::EpiMoe1 E{hid, lists, rsc, gatew};
            pg8::gemm_phase(lds, hb, D, Sm, E);
        } else {
            pg8::MoeSched<false> Sm{4, G, bid, 512, wex + WEX_WD, WD_SZ, lists, moe};
            pg8::EpiMoe2 E{ys, lists};
            pg8::gemm_phase(lds, hid, 512, Sm, E);
        }
        __syncthreads();
    }
    if constexpr (PH == PH_FIN) {
        bf16* hbo = PRB ? (bf16*)(ws + WS_Z + 224 * MiB) : hb; float* sso = PRB ? (float*)(ws + WS_Z + 260 * MiB) : ssqp;
        for (int r = gw; r < S; r += NGW) {
            float4 v[4]; float ss = 0.f;
            const u32x2* hr = (const u32x2*)(hb + (size_t)r * D);
            const u32x2* y0 = (const u32x2*)(ys + (size_t)(2 * r) * D); const u32x2* y1 = (const u32x2*)(ys + (size_t)(2 * r + 1) * D);
#pragma unroll
            for (int j = 0; j < 4; ++j) {
                const u32x2 c = hr[lane + 64 * j], a = y0[lane + 64 * j], b = y1[lane + 64 * j];
                v[j].x = __uint_as_float(c.x << 16) + (__uint_as_float(a.x << 16) + __uint_as_float(b.x << 16)); v[j].y = __uint_as_float(c.x & 0xffff0000u) + (__uint_as_float(a.x & 0xffff0000u) + __uint_as_float(b.x & 0xffff0000u));
                v[j].z = __uint_as_float(c.y << 16) + (__uint_as_float(a.y << 16) + __uint_as_float(b.y << 16)); v[j].w = __uint_as_float(c.y & 0xffff0000u) + (__uint_as_float(a.y & 0xffff0000u) + __uint_as_float(b.y & 0xffff0000u));
                ss += v[j].x * v[j].x + v[j].y * v[j].y + v[j].z * v[j].z + v[j].w * v[j].w;
            }
            ss = wave_sum(ss);
            if (layer == DEPTH - 1) {
                const float rs = rsqrtf(ss * (1.0f / D) + 1e-6f); float4* o4 = (float4*)(p.out + (size_t)r * D);
#pragma unroll
                for (int j = 0; j < 4; ++j) { const float4 gg = ((const float4*)p.ln_final)[lane + 64 * j]; float4 o; o.x = v[j].x * rs * gg.x; o.y = v[j].y * rs * gg.y; o.z = v[j].z * rs * gg.z; o.w = v[j].w * rs * gg.w; o4[lane + 64 * j] = o; }
            } else {
                rms_row_bf16(v, 1.0f, nullptr, hbo + (size_t)r * D, lane);
                if (lane < 16) sso[(size_t)r * 16 + lane] = lane == 0 ? ss : 0.f;
            }
        }
    }
}

__global__ void __launch_bounds__(NT, 2) k_mega(Params p) {
    extern __shared__ __attribute__((aligned(16))) unsigned char lds_[];
    LAS unsigned char* lds = (LAS unsigned char*)lds_;
    if (threadIdx.x < 4) ((LAS unsigned*)(lds + LDS_BARW))[threadIdx.x] = 0u;
    __syncthreads();
    XcdBarrier bar = xcd_barrier_post((unsigned*)(p.ws + WS_CTL) + CW_BAR, (volatile LAS unsigned*)(lds + LDS_BARW));
#ifndef PROBE_PH
#define PROBE_PH -1
#endif
#define PHX(PH, l, BAR) do { run_phase<PH>(l, lds); if (BAR) xcd_barrier(bar); else __syncthreads(); \
        if (PH == PROBE_PH) { run_phase<PH, true>(l, lds); if (BAR) xcd_barrier(bar); else __syncthreads(); } \
        if (PROBE_PH == -2 && (BAR)) xcd_barrier(bar); } while (0)
#define PHB(PH, l) PHX(PH, l, true)
    PHB(PH_INIT, 0);
    for (int l = 0; l < DEPTH; ++l) {
        PHB(PH_GEMM1, l);
        if ((l & 1) == 0) { PHX(PH_SGU, l, false); PHB(PH_WATT, l); } else { PHB(PH_DATT, l); PHB(PH_COMB, l); }
        PHB(PH_GEMM2, l); PHB(PH_GEMM3, l); PHB(PH_XATT, l); PHB(PH_GEMM4, l);
        PHB(PH_ROUTE, l); PHB(PH_MOE1, l); PHB(PH_MOE2, l);
        if (l == DEPTH - 1) run_phase<PH_FIN>(l, lds); else PHB(PH_FIN, l);
    }
#undef PHX
#undef PHB
}

extern "C" void kernel_launch(void* const* d_in, const int* in_sizes, int n_in, void* d_out, int out_size, void* d_ws, size_t ws_size, hipStream_t stream) {
    if (n_in != 27 || ws_size < WS_END) { fprintf(stderr, "kernel_launch: unexpected n_in %d or ws_size %zu\n", n_in, ws_size); return; }
    Params p{};
    const float** pp = (const float**)&p;
    for (int i = 0; i < 27; ++i) pp[i] = (const float*)d_in[i];
    p.out = (float*)d_out; p.ws = (unsigned char*)d_ws;
    (void)hipMemsetAsync((char*)d_ws + WS_CTL, 0, 1 * MiB, stream);
    static int grid = 0;
    if (grid == 0) {
        int dev = 0, cus = 0, per_cu = 0;
        if (hipGetDevice(&dev) != hipSuccess || hipDeviceGetAttribute(&cus, hipDeviceAttributeMultiprocessorCount, dev) != hipSuccess) { grid = -1; return; }
        if (hipFuncSetAttribute((const void*)k_mega, hipFuncAttributeMaxDynamicSharedMemorySize, LDS_BYTES) != hipSuccess) { fprintf(stderr, "hipFuncSetAttribute failed\n"); grid = -1; return; }
        if (hipOccupancyMaxActiveBlocksPerMultiprocessor(&per_cu, (const void*)k_mega, NT, LDS_BYTES) != hipSuccess || per_cu < 1) { fprintf(stderr, "occupancy query: %d\n", per_cu); grid = -1; return; }
        (void)hipGetLastError();
        grid = cus;
    }
    if (grid < 0) return;
    hipLaunchKernelGGL(k_mega, dim3(grid), dim3(NT), LDS_BYTES, stream, p);
}
```
